# Optimizing an MI355X kernel written in HIP

```python
import jax
import jax.numpy as jnp
from jax import lax
import numpy as np

D_MODEL = 2048
BATCH = 2
SEQ = 4096
DEPTH = 2
DEC_BATCH = 32
DEC_SEQ = 1
PAST_LEN = 8192
PAGE_SIZE = 128

N_A_LAYERS = DEPTH // 2
N_B_LAYERS = DEPTH - N_A_LAYERS
CHUNK = 128
D_A = D_MODEL
A_GROUPS = 16
A_GROUP_DIM = D_A // A_GROUPS
HEAD_DIM = 128
N_HEADS = D_MODEL // HEAD_DIM
N_KV = 2
Q_PER_KV = N_HEADS // N_KV
CMP_STRIDE = 16
CMP_BLOCK = 2 * CMP_STRIDE
SLC_BLOCK = 64
N_SELECT = 16
WINDOW = 512
N_BRANCH = 3
KV_ALIGN = 64
ROT_DIM = HEAD_DIM // 4
ROPE_THETA = 500000.0
Q_BLOCK = 128
D_FF = 4 * D_MODEL
EPS = 1e-6
NEG = -1e30
FORCE_BONUS = 1e4

kernel_name = 'yoco_gmlp_nsa_step'


def rms_norm(x, g):
    xf = x.astype(jnp.float32)
    y = xf * lax.rsqrt(jnp.mean(xf * xf, axis=-1, keepdims=True) + EPS)
    return (y * g.astype(jnp.float32)).astype(x.dtype)


def rope(x, pos):
    inv = ROPE_THETA ** (-jnp.arange(0, ROT_DIM, 2, dtype=jnp.float32) / ROT_DIM)
    ang = pos.astype(jnp.float32)[:, None] * inv[None, :]
    cos = jnp.cos(ang)[None, :, None, :]
    sin = jnp.sin(ang)[None, :, None, :]
    xr = x[..., :ROT_DIM].astype(jnp.float32)
    x1, x2 = xr[..., :ROT_DIM // 2], xr[..., ROT_DIM // 2:]
    rot = jnp.concatenate([x1 * cos - x2 * sin, x2 * cos + x1 * sin], axis=-1).astype(x.dtype)
    return jnp.concatenate([rot, x[..., ROT_DIM:]], axis=-1)


def sqrelu_mlp(x, g, w_up, w_down):
    h = rms_norm(x, g) @ w_up
    return x + jnp.square(jax.nn.relu(h)) @ w_down


def chunk_gmlp(x, g, w_in, v_g, w_s, b_s, w_out):
    B, T, _ = x.shape
    z = jax.nn.gelu(rms_norm(x, g) @ w_in)
    u, v = z[..., :D_A], z[..., D_A:]
    v = rms_norm(v, v_g)
    pad = (-T) % CHUNK
    nc = (T + pad) // CHUNK
    vc = jnp.pad(v, ((0, 0), (0, pad), (0, 0))).reshape(B, nc, CHUNK, A_GROUPS, A_GROUP_DIM)
    causal = jnp.tril(jnp.ones((CHUNK, CHUNK), dtype=bool))
    ws = jnp.where(causal[None], w_s, 0.0)
    mixed = jnp.einsum('gts,bcsgd->bctgd', ws, vc) + b_s.T[None, None, :, :, None]
    mixed = mixed.reshape(B, nc * CHUNK, D_A)[:, :T]
    return x + (u * mixed) @ w_out, v


def shared_kv_rows(h, pos, kv_g, w_kv, k_norm):
    B, T, _ = h.shape
    kv = (rms_norm(h, kv_g) @ w_kv).reshape(B, T, 6, N_KV, HEAD_DIM)
    k_slc = rope(rms_norm(kv[:, :, 2], k_norm[1]), pos)
    k_win = rope(rms_norm(kv[:, :, 4], k_norm[2]), pos)
    paged = jnp.stack([kv[:, :, 0], kv[:, :, 1], k_slc, kv[:, :, 3]], axis=2)
    win = jnp.stack([k_win, kv[:, :, 5]], axis=2)
    return paged, win


def compress(rows, pe, w1, w2):
    B, Tk = rows.shape[:2]
    sub = rows.reshape(B, Tk // CMP_STRIDE, CMP_STRIDE, N_KV, HEAD_DIM)
    first = jnp.einsum('bnrgd,rde->bnge', sub, w1[:CMP_STRIDE])
    second = jnp.einsum('bnrgd,rde->bnge', sub, w1[CMP_STRIDE:])
    bias = jnp.einsum('rd,rde->e', pe, w1)
    h = jax.nn.silu(first[:, :-1] + second[:, 1:] + bias)
    return h @ w2


def nsa_keys(rows, cmp_pe, cmp_w1, cmp_w2, k_norm):
    B, Tp = rows.shape[:2]
    kc = compress(rows[:, :, 0], cmp_pe[0], cmp_w1[0], cmp_w2[0])
    vc = compress(rows[:, :, 1], cmp_pe[1], cmp_w1[1], cmp_w2[1])
    n_cmp = kc.shape[1]
    cmp_pos = jnp.arange(n_cmp) * CMP_STRIDE + CMP_BLOCK - 1
    kc = rope(rms_norm(kc, k_norm[0]), cmp_pos)
    n_slc = Tp // SLC_BLOCK
    kb = rows[:, :, 2].reshape(B, n_slc, SLC_BLOCK, N_KV, HEAD_DIM).transpose(0, 3, 1, 2, 4)
    vb = rows[:, :, 3].reshape(B, n_slc, SLC_BLOCK, N_KV, HEAD_DIM).transpose(0, 3, 1, 2, 4)
    ci = jnp.arange(n_cmp)[:, None] * CMP_STRIDE
    sj = jnp.arange(n_slc)[None, :] * SLC_BLOCK
    overlap = ((ci < sj + SLC_BLOCK) & (ci + CMP_BLOCK > sj)).astype(jnp.float32)
    return kc, vc, cmp_pos, kb, vb, overlap


def nsa_queries(h, pos, g, w_in, q_g):
    B, T, _ = h.shape
    z = rms_norm(h, g) @ w_in
    q = z[..., :N_HEADS * HEAD_DIM].reshape(B, T, N_HEADS, HEAD_DIM)
    q = rope(rms_norm(q, q_g), pos)
    gates = jax.nn.sigmoid(z[..., N_HEADS * HEAD_DIM:].astype(jnp.float32)).astype(h.dtype)
    return q, gates.reshape(B, T, N_HEADS, N_BRANCH)


def nsa_attend(q, qpos, gates, kc, vc, cmp_pos, kb, vb, overlap, kw, vw, kw_pos):
    B, Tq = q.shape[:2]
    scale = HEAD_DIM ** -0.5
    qg = q.reshape(B, Tq, N_KV, Q_PER_KV, HEAD_DIM)
    t = qpos[:, None]
    s_c = jnp.einsum('bqgrd,bngd->bqgrn', qg, kc).astype(jnp.float32) * scale
    m_c = (cmp_pos[None, :] <= t)[None, :, None, None, :]
    p_c = jnp.where(m_c, jax.nn.softmax(jnp.where(m_c, s_c, NEG), axis=-1), 0.0)
    o_c = jnp.einsum('bqgrn,bngd->bqgrd', p_c.astype(vc.dtype), vc)
    imp = jnp.einsum('bqgn,ns->bqgs', p_c.sum(axis=3), overlap)
    n_slc = kb.shape[2]
    blk = jnp.arange(n_slc)[None, :]
    cur = t // SLC_BLOCK
    causal = (blk * SLC_BLOCK <= t)[None, :, None, :]
    forced = ((blk == 0) | (blk == cur) | (blk == cur - 1))[None, :, None, :]
    score = jnp.where(causal, imp + jnp.where(forced, FORCE_BONUS, 0.0), NEG)
    k_sel = min(N_SELECT, n_slc)
    vals, idx = lax.top_k(score, k_sel)
    sel_ok = vals > 0.5 * NEG
    idx_t = idx.transpose(0, 2, 1, 3).reshape(B, N_KV, Tq * k_sel)
    bi = jnp.arange(B)[:, None, None]
    gi = jnp.arange(N_KV)[None, :, None]
    ks = kb[bi, gi, idx_t].reshape(B, N_KV, Tq, k_sel, SLC_BLOCK, HEAD_DIM)
    vs = vb[bi, gi, idx_t].reshape(B, N_KV, Tq, k_sel, SLC_BLOCK, HEAD_DIM)
    s_s = jnp.einsum('bqgrd,bgqkld->bqgrkl', qg, ks).astype(jnp.float32) * scale
    tok = idx[..., None] * SLC_BLOCK + jnp.arange(SLC_BLOCK)
    m_s = sel_ok[..., None] & (tok <= qpos[None, :, None, None, None])
    s_s = jnp.where(m_s[:, :, :, None], s_s, NEG).reshape(B, Tq, N_KV, Q_PER_KV, k_sel * SLC_BLOCK)
    p_s = jax.nn.softmax(s_s, axis=-1).reshape(B, Tq, N_KV, Q_PER_KV, k_sel, SLC_BLOCK)
    o_s = jnp.einsum('bqgrkl,bgqkld->bqgrd', p_s.astype(vs.dtype), vs)
    s_w = jnp.einsum('bqgrd,bkgd->bqgrk', qg, kw).astype(jnp.float32) * scale
    dist = t - kw_pos[None, :]
    m_w = ((dist >= 0) & (dist < WINDOW) & (kw_pos[None, :] >= 0))[None, :, None, None, :]
    p_w = jax.nn.softmax(jnp.where(m_w, s_w, NEG), axis=-1)
    o_w = jnp.einsum('bqgrk,bkgd->bqgrd', p_w.astype(vw.dtype), vw)
    g = gates.reshape(B, Tq, N_KV, Q_PER_KV, N_BRANCH)
    out = g[..., 0:1] * o_c + g[..., 1:2] * o_s + g[..., 2:3] * o_w
    return out.reshape(B, Tq, N_HEADS, HEAD_DIM)


def nsa_prompt(q, gates, keys, win):
    B, T = q.shape[:2]
    win_pad = jnp.pad(win, ((0, 0), (WINDOW, 0), (0, 0), (0, 0), (0, 0)))

    def one_block(qb):
        s = qb * Q_BLOCK
        qpos = s + jnp.arange(Q_BLOCK)
        q_b = lax.dynamic_slice_in_dim(q, s, Q_BLOCK, axis=1)
        g_b = lax.dynamic_slice_in_dim(gates, s, Q_BLOCK, axis=1)
        w_b = lax.dynamic_slice_in_dim(win_pad, s, Q_BLOCK + WINDOW, axis=1)
        kw_pos = s - WINDOW + jnp.arange(Q_BLOCK + WINDOW)
        return nsa_attend(q_b, qpos, g_b, *keys, w_b[:, :, 0], w_b[:, :, 1], kw_pos)

    out = lax.map(one_block, jnp.arange(T // Q_BLOCK))
    return out.transpose(1, 0, 2, 3, 4).reshape(B, T, N_HEADS, HEAD_DIM)


def setup_inputs(seed: int = 0) -> dict:
    key = jax.random.key(seed)
    ks = jax.random.split(key, 24)
    n_pages = PAST_LEN // PAGE_SIZE
    n_pool = (5 * DEC_BATCH * n_pages + 3) // 4
    win_keep = min(WINDOW, PAST_LEN)

    def nrm(k, shape, scale):
        return scale * jax.random.normal(k, shape, jnp.float32)

    def gain(k, shape):
        return 1.0 + 0.02 * jax.random.normal(k, shape, jnp.float32)

    page_table = jax.random.permutation(ks[4], n_pool)[:DEC_BATCH * n_pages]
    page_table = page_table.reshape(DEC_BATCH, n_pages).astype(jnp.int32)
    return {
        'x_prompt': nrm(ks[0], (BATCH, SEQ, D_MODEL), 1.0),
        'x_sample': nrm(ks[1], (DEC_BATCH, DEC_SEQ, D_MODEL), 1.0),
        'cache_kv': nrm(ks[2], (n_pool, PAGE_SIZE, 4, N_KV, HEAD_DIM), 1.0),
        'state_kv_win': nrm(ks[3], (DEC_BATCH, win_keep, 2, N_KV, HEAD_DIM), 1.0),
        'page_table': page_table,
        'a_norm': gain(ks[5], (N_A_LAYERS, D_MODEL)),
        'a_w_in': nrm(ks[6], (N_A_LAYERS, D_MODEL, 2 * D_A), D_MODEL ** -0.5),
        'a_v_norm': gain(ks[7], (N_A_LAYERS, D_A)),
        'a_w_s': nrm(ks[8], (N_A_LAYERS, A_GROUPS, CHUNK, CHUNK), CHUNK ** -0.5),
        'a_b_s': gain(ks[9], (N_A_LAYERS, A_GROUPS, CHUNK)),
        'a_w_out': nrm(ks[10], (N_A_LAYERS, D_A, D_MODEL), D_A ** -0.5),
        'mlp_norm': gain(ks[11], (DEPTH, D_MODEL)),
        'mlp_w_up': nrm(ks[12], (DEPTH, D_MODEL, D_FF), D_MODEL ** -0.5),
        'mlp_w_down': nrm(ks[13], (DEPTH, D_FF, D_MODEL), D_FF ** -0.5),
        'kv_norm': gain(ks[14], (D_MODEL,)),
        'w_kv': nrm(ks[15], (D_MODEL, 6 * N_KV * HEAD_DIM), D_MODEL ** -0.5),
        'cmp_pe': nrm(ks[16], (2, CMP_BLOCK, HEAD_DIM), 0.1),
        'cmp_w1': nrm(ks[17], (2, CMP_BLOCK, HEAD_DIM, HEAD_DIM), (CMP_BLOCK * HEAD_DIM) ** -0.5),
        'cmp_w2': nrm(ks[18], (2, HEAD_DIM, HEAD_DIM), HEAD_DIM ** -0.5),
        'k_norm': gain(ks[19], (3, HEAD_DIM)),
        'b_norm': gain(ks[20], (N_B_LAYERS, D_MODEL)),
        'b_w_in': nrm(ks[21], (N_B_LAYERS, D_MODEL, N_HEADS * HEAD_DIM + N_BRANCH * N_HEADS), D_MODEL ** -0.5),
        'b_q_norm': gain(ks[22], (N_B_LAYERS, HEAD_DIM)),
        'b_w_out': nrm(ks[23], (N_B_LAYERS, N_HEADS * HEAD_DIM, D_MODEL), (N_HEADS * HEAD_DIM) ** -0.5),
    }


def reference(x_prompt, x_sample, cache_kv, state_kv_win, page_table, a_norm, a_w_in, a_v_norm,
              a_w_s, a_b_s, a_w_out, mlp_norm, mlp_w_up, mlp_w_down, kv_norm, w_kv, cmp_pe,
              cmp_w1, cmp_w2, k_norm, b_norm, b_w_in, b_q_norm, b_w_out):
    bp, T = x_prompt.shape[:2]
    bd, td = x_sample.shape[:2]
    past_len = page_table.shape[1] * cache_kv.shape[1]
    win_keep_s = state_kv_win.shape[1]
    pos_p = jnp.arange(T)
    pos_s = past_len + jnp.arange(td)
    h_p, h_s = x_prompt, x_sample
    v_rows_s = []
    for layer in range(DEPTH):
        if layer < N_A_LAYERS:
            h_p, _ = chunk_gmlp(h_p, a_norm[layer], a_w_in[layer], a_v_norm[layer],
                                a_w_s[layer], a_b_s[layer], a_w_out[layer])
            h_s, v_s = chunk_gmlp(h_s, a_norm[layer], a_w_in[layer], a_v_norm[layer],
                                  a_w_s[layer], a_b_s[layer], a_w_out[layer])
            v_rows_s.append(v_s)
        else:
            if layer == N_A_LAYERS:
                kv_p, win_p = shared_kv_rows(h_p, pos_p, kv_norm, w_kv, k_norm)
                kv_s, win_s = shared_kv_rows(h_s, pos_s, kv_norm, w_kv, k_norm)
                pad_p = (-T) % KV_ALIGN
                rows_p = jnp.pad(kv_p, ((0, 0), (0, pad_p), (0, 0), (0, 0), (0, 0)))
                keys_p = nsa_keys(rows_p, cmp_pe, cmp_w1, cmp_w2, k_norm)
                past = cache_kv[page_table].reshape(bd, past_len, 4, N_KV, HEAD_DIM)
                pad_s = (-(past_len + td)) % KV_ALIGN
                rows_s = jnp.concatenate(
                    [past, kv_s, jnp.zeros((bd, pad_s, 4, N_KV, HEAD_DIM), past.dtype)], axis=1)
                keys_s = nsa_keys(rows_s, cmp_pe, cmp_w1, cmp_w2, k_norm)
                win_all_s = jnp.concatenate([state_kv_win, win_s], axis=1)
                kw_pos_s = past_len - win_keep_s + jnp.arange(win_keep_s + td)
            j = layer - N_A_LAYERS
            q, g = nsa_queries(h_p, pos_p, b_norm[j], b_w_in[j], b_q_norm[j])
            o = nsa_prompt(q, g, keys_p, win_p)
            h_p = h_p + o.reshape(bp, T, N_HEADS * HEAD_DIM) @ b_w_out[j]
            q, g = nsa_queries(h_s, pos_s, b_norm[j], b_w_in[j], b_q_norm[j])
            o = nsa_attend(q, pos_s, g, *keys_s, win_all_s[:, :, 0], win_all_s[:, :, 1], kw_pos_s)
            h_s = h_s + o.reshape(bd, td, N_HEADS * HEAD_DIM) @ b_w_out[j]
        h_p = sqrelu_mlp(h_p, mlp_norm[layer], mlp_w_up[layer], mlp_w_down[layer])
        h_s = sqrelu_mlp(h_s, mlp_norm[layer], mlp_w_up[layer], mlp_w_down[layer])
    win_new_p = win_p[:, T - min(WINDOW, T):]
    win_new_s = win_all_s[:, td:]
    v_a_s = jnp.stack(v_rows_s, axis=0)
    return (h_p, h_s, kv_p, win_new_p, kv_s, win_new_s, v_a_s)
```

```cpp
#include <hip/hip_runtime.h>
#include <cstdio>
#include <cstdint>

#define GAS __attribute__((address_space(1)))
#define LAS __attribute__((address_space(3)))
typedef unsigned short bf16;
typedef short bf16x8 __attribute__((ext_vector_type(8)));
typedef float f32x4 __attribute__((ext_vector_type(4)));
typedef float f32x2 __attribute__((ext_vector_type(2)));
typedef float f32x16 __attribute__((ext_vector_type(16)));
typedef unsigned u32x4 __attribute__((ext_vector_type(4)));
typedef unsigned u32x2 __attribute__((ext_vector_type(2)));

constexpr int D = 2048, T = 4096, MP = 8192, MS = 32, DFF = 8192, NKVQ = 3840, HD = 128;
constexpr int PASTL = 8192, NPAGE = 64;
constexpr float EPS = 1e-6f;
constexpr size_t O_YP = 0, O_YS = 16777216, O_KVP = 16842752, O_WINP = 25231360, O_KVS = 25755648, O_WINS = 25788416, O_VAS = 34177024;
constexpr int LDS_BYTES = 147456;
constexpr int MISC_OFF = 139264;
constexpr int NT = 512;

__device__ __forceinline__ unsigned f2bf(float f) { unsigned u = __builtin_bit_cast(unsigned, f); return (u + 0x7fffu + ((u >> 16) & 1u)) >> 16; }
__device__ __forceinline__ unsigned pk2(float lo, float hi) { return f2bf(lo) | (f2bf(hi) << 16); }
__device__ __forceinline__ float bf2f(unsigned b) { return __builtin_bit_cast(float, b << 16); }
__device__ __forceinline__ float wave_sum(float v) {
#pragma unroll
    for (int o = 1; o < 64; o <<= 1) v += __shfl_xor(v, o);
    return v;
}
__device__ __forceinline__ float wave_max(float v) {
#pragma unroll
    for (int o = 1; o < 64; o <<= 1) v = fmaxf(v, __shfl_xor(v, o));
    return v;
}
__device__ __forceinline__ float gelu_t(float x) { const float y = 0.7978845608028654f * (x + 0.044715f * x * x * x); const float e = __expf(2.f * y); const float t = 1.f - 2.f / (e + 1.f); return 0.5f * x * (1.f + t); }
__device__ __forceinline__ float silu_f(float x) { return x / (1.f + __expf(-x)); }
__device__ __forceinline__ float sigmoid_f(float x) { return 1.f / (1.f + __expf(-x)); }
#define LDS_WAIT() asm volatile("s_waitcnt lgkmcnt(0)" ::: "memory")
#define VM_WAIT() asm volatile("s_waitcnt vmcnt(0)" ::: "memory")

#define XB_TMO      128
#define XB_XCNT(j)  (256  + 64 * (j))
#define XB_XSUB(j)  (1280 + 64 * (j))
#define XB_XGEN(j)  (2304 + 64 * (j))
#define XB_TOP      3328
#define XB_TOPGEN   3392
#define XCD_BAR_WORDS 3456
#define XB_SPIN_CAP (1u << 18)

__device__ __forceinline__ unsigned xb_ld(unsigned* p)              { return __hip_atomic_load(p, __ATOMIC_RELAXED, __HIP_MEMORY_SCOPE_AGENT); }
__device__ __forceinline__ unsigned xb_add(unsigned* p, unsigned v) { return __hip_atomic_fetch_add(p, v, __ATOMIC_RELAXED, __HIP_MEMORY_SCOPE_AGENT); }
__device__ __forceinline__ unsigned xb_xcc_id() { return (unsigned)__builtin_amdgcn_s_getreg((3 << 11) | 20) & 0xFu; }
#define XB_SPIN(cond, bar) do { unsigned _sp = 0; while (cond) { __builtin_amdgcn_s_sleep(1); \
    if ((++_sp & 255u) == 0u) { if (xb_ld(&(bar)[XB_TMO])) break; if (_sp > XB_SPIN_CAP) { atomicAdd(&(bar)[XB_TMO], 1u); break; } } } } while (0)

struct XcdBarrier {
    unsigned* bar; unsigned x;
    volatile LAS unsigned* st;
};

__device__ __forceinline__ XcdBarrier xcd_barrier_post(unsigned* bar, volatile LAS unsigned* st) {
    XcdBarrier b; b.bar = bar; b.x = xb_xcc_id(); b.st = st;
    if (threadIdx.x == 0) (void)xb_add(&bar[XB_XCNT(b.x)], 1u);
    return b;
}
__device__ __forceinline__ void xcd_barrier_complete(unsigned* bar, unsigned x, unsigned& nloc, unsigned& nx) {
    const unsigned G = gridDim.x * gridDim.y * gridDim.z;
    unsigned sum, cnt, mine, sp = 0u;
    for (;;) {
        sum = 0u; cnt = 0u; mine = 0u;
#pragma unroll
        for (unsigned j = 0; j < 16; ++j) { const unsigned c = xb_ld(&bar[XB_XCNT(j)]); sum += c; cnt += (c > 0u) ? 1u : 0u; mine = (j == x) ? c : mine; }
        if (sum == G) break;
        __builtin_amdgcn_s_sleep(1);
        if ((++sp & 255u) == 0u) { if (xb_ld(&bar[XB_TMO])) break; if (sp > XB_SPIN_CAP) { atomicAdd(&bar[XB_TMO], 1u); break; } }
    }
    nloc = mine > 0u ? mine : 1u; nx = cnt > 0u ? cnt : 1u;
}

__device__ __forceinline__ void xcd_barrier(const XcdBarrier& b) {
    asm volatile("s_waitcnt vmcnt(0)" ::: "memory");
    __syncthreads();
    if (threadIdx.x == 0) {
        unsigned* bar = b.bar;
        __builtin_amdgcn_s_waitcnt(0);
        unsigned nloc = b.st[0], nx = b.st[1];
        if (nloc == 0u) { xcd_barrier_complete(bar, b.x, nloc, nx); b.st[0] = nloc; b.st[1] = nx; }
        const unsigned old = xb_add(&bar[XB_XSUB(b.x)], 1u);
        const unsigned gen = old / nloc;
        if (old + 1u == (gen + 1u) * nloc) {
            __builtin_amdgcn_fence(__ATOMIC_RELEASE, "agent");
            asm volatile("s_waitcnt vmcnt(0)" ::: "memory");
            const unsigned og = xb_add(&bar[XB_TOP], 1u);
            const unsigned tg = og / nx;
            if (og + 1u == (tg + 1u) * nx) xb_add(&bar[XB_TOPGEN], 1u);
            else XB_SPIN(xb_ld(&bar[XB_TOPGEN]) == tg, bar);
            __builtin_amdgcn_fence(__ATOMIC_ACQUIRE, "agent");
            xb_add(&bar[XB_XGEN(b.x)], 1u);
            asm volatile("s_waitcnt vmcnt(0)" ::: "memory");
        } else {
            XB_SPIN(xb_ld(&bar[XB_XGEN(b.x)]) == gen, bar);
            __builtin_amdgcn_fence(__ATOMIC_ACQUIRE, "agent");
            asm volatile("s_waitcnt vmcnt(0)" ::: "memory");
        }
    }
    __syncthreads();
}

namespace pg8 {
#define PG8_LAS __attribute__((address_space(3)))
typedef unsigned short bf16_t;
constexpr int BM = 256, BK = 64, HALF = 128, HTB = HALF * BK * 2  , STAGE_BYTES = 8 * HTB, NXCD = 8, WGM = 8;

__host__ __device__ __forceinline__ int lds_byte(int r, int c) { const int st = (r >> 4) * 2 + (c >> 5), rr = r & 15, cc = c & 31, ob = rr * 64 + cc * 2; return st * 1024 + (ob ^ (((ob >> 9) & 1) << 5)); }
__host__ __device__ __forceinline__ void stage_rc(int b, int& R, int& C) { const int st = b / 1024, sb = b % 1024, swz = sb ^ (((sb >> 9) & 1) << 5); R = (st >> 1) * 16 + swz / 64; C = (st & 1) * 32 + (swz % 64) / 2; }
__host__ __device__ __forceinline__ int perm32(int rho) { const int n = rho >> 4, i = rho & 15; return 8 * (i >> 2) + 4 * n + (i & 3); }

struct Unit { int pm, pn; };
struct Gemm { const bf16_t* A; const bf16_t* Bt; int M, N, K, lda, ldb; };

struct StaticOrder {
    int nM, nN, nwg, G, c;
    __host__ __device__ void init(int M, int N, int G_, int c_) { nM = M / BM; nN = N / BM; nwg = nM * nN; G = G_; c = c_; }
    __host__ __device__ bool next(int i, Unit& u) const {
        const long L = (long)i * G + c; if (L >= nwg) return false;
        int wgid = (int)L; { const int q = nwg / NXCD, r = nwg % NXCD, xcd = wgid % NXCD, off = wgid / NXCD; wgid = (xcd < r ? xcd * (q + 1) : r * (q + 1) + (xcd - r) * q) + off; }
        const int nig = WGM * nN, gid = wgid / nig, fm = gid * WGM, gsz = (nM - fm) < WGM ? (nM - fm) : WGM;
        u.pm = fm + ((wgid % nig) % gsz); u.pn = (wgid % nig) / gsz; return true;
    }
    __device__ __forceinline__ void a_ready(const Unit&) const {}
    __device__ __forceinline__ void done(const Unit&) const {}
};
struct DiagOrder {
    int nunits, per, G, c;
    __device__ __forceinline__ bool next(int i, Unit& u) const { const int L = i * G + c; if (L >= nunits) return false; u.pm = L; u.pn = L / per; return true; }
    __device__ __forceinline__ void a_ready(const Unit&) const {}
    __device__ __forceinline__ void done(const Unit&) const {}
};

template <class Epi, class Sched, bool ALIGN_EPI = false, bool SP2 = false>
__device__ __forceinline__ void gemm_phase(PG8_LAS unsigned char* lds, const Gemm g, const Sched& S, const Epi& E) {
    const int tid = threadIdx.x, wid = __builtin_amdgcn_readfirstlane(tid >> 6), lane = tid & 63, wr = wid >> 2, wc = wid & 3, fr = lane & 15, fq = lane >> 4;
    const int K = g.K, nt = K / BK;
    unsigned voffA[2], voffB[2];
#pragma unroll
    for (int i = 0; i < 2; ++i) { int R, C; stage_rc(tid * 16 + i * 8192, R, C); const int Rb = Epi::PERM ? ((R & ~31) + perm32(R & 31)) : R;
        voffA[i] = (unsigned)(R * g.lda + C) * 2u; voffB[i] = (unsigned)(Rb * g.ldb + C) * 2u; }
    const size_t kstep = (size_t)(BK * 2);
    const size_t hstepA = (size_t)HALF * g.lda * 2, hstepB = (size_t)HALF * g.ldb * 2;
    const size_t tstepA = 2 * hstepA, tstepB = 2 * hstepB;
    const unsigned ldsw = (unsigned)wid * 1024u;
    const int aoff = lds_byte(wr * 64 + fr, fq * 8), boff = lds_byte(wc * 32 + fr, fq * 8);
#define PG8_SA(b, h) (((b) * 2 + (h)) * HTB)
#define PG8_SB(b, h) ((4 + (b) * 2 + (h)) * HTB)
#define PG8_STAGE(bufoff, gbase, voff) do { _Pragma("unroll") for (int _i = 0; _i < 2; ++_i) \
        __builtin_amdgcn_global_load_lds((const unsigned*)((const char*)(gbase) + (voff)[_i]), (PG8_LAS unsigned*)(lds + (bufoff) + ldsw + _i * 8192), 16, 0, 0); } while (0)
#define PG8_LDA(dst, b, h) do { _Pragma("unroll") for (int m = 0; m < 4; ++m) _Pragma("unroll") for (int k = 0; k < 2; ++k) dst[m][k] = *(const PG8_LAS bf16x8*)(lds + PG8_SA(b, h) + aoff + m * 2048 + k * 1024); } while (0)
#define PG8_LDB(dst, b, h) do { _Pragma("unroll") for (int n = 0; n < 2; ++n) _Pragma("unroll") for (int k = 0; k < 2; ++k) dst[n][k] = *(const PG8_LAS bf16x8*)(lds + PG8_SB(b, h) + boff + n * 2048 + k * 1024); } while (0)
#define PG8_MMA(ai, bj, At, Bt) do { __builtin_amdgcn_s_setprio(1); _Pragma("unroll") for (int m = 0; m < 4; ++m) _Pragma("unroll") for (int n = 0; n < 2; ++n) _Pragma("unroll") for (int k = 0; k < 2; ++k) \
        acc[ai][bj][m][n] = __builtin_amdgcn_mfma_f32_16x16x32_bf16(Bt[n][k], At[m][k], acc[ai][bj][m][n], 0, 0, 0); __builtin_amdgcn_s_setprio(0); } while (0)
#define PG8_WAIT_V(n) asm volatile("s_waitcnt vmcnt(" #n ")" ::: "memory")
#define PG8_WAIT_L(n) asm volatile("s_waitcnt lgkmcnt(" #n ")" ::: "memory")
#define PG8_BAR __builtin_amdgcn_s_barrier()
#define PG8_SCHED __builtin_amdgcn_sched_barrier(0)
    Unit cur, nxt; int ui = 0;
    if (!S.next(0, cur)) return;
    f32x4 acc[2][2][4][2];
#pragma unroll
    for (int a = 0; a < 2; ++a)
#pragma unroll
        for (int b = 0; b < 2; ++b)
#pragma unroll
            for (int m = 0; m < 4; ++m)
#pragma unroll
                for (int n = 0; n < 2; ++n) acc[a][b][m][n] = (f32x4){0.f, 0.f, 0.f, 0.f};
    bf16x8 At[4][2], B0[2][2], B1[2][2];
    const char* cA = (const char*)g.A + (size_t)cur.pm * tstepA; const char* cB = (const char*)g.Bt + (size_t)cur.pn * tstepB;
    S.a_ready(cur);
    if constexpr (SP2) {
        PG8_STAGE(PG8_SB(0, 0), cB, voffB); PG8_STAGE(PG8_SB(0, 1), cB + hstepB, voffB); PG8_STAGE(PG8_SA(0, 0), cA, voffA); PG8_STAGE(PG8_SA(0, 1), cA + hstepA, voffA);
        if (wr == 1) PG8_BAR;
        PG8_WAIT_V(2); PG8_BAR;
        PG8_STAGE(PG8_SB(1, 0), cB + kstep, voffB); PG8_STAGE(PG8_SA(1, 0), cA + kstep, voffA); PG8_STAGE(PG8_SB(1, 1), cB + hstepB + kstep, voffB);
        PG8_WAIT_V(6); PG8_BAR;
    } else {
        PG8_STAGE(PG8_SB(0, 0), cB, voffB); PG8_STAGE(PG8_SA(0, 0), cA, voffA); PG8_STAGE(PG8_SB(0, 1), cB + hstepB, voffB); PG8_STAGE(PG8_SA(0, 1), cA + hstepA, voffA);
        if (wr == 1) PG8_BAR;
        PG8_WAIT_V(4); PG8_BAR;
        PG8_STAGE(PG8_SB(1, 0), cB + kstep, voffB); PG8_STAGE(PG8_SA(1, 0), cA + kstep, voffA); PG8_STAGE(PG8_SB(1, 1), cB + hstepB + kstep, voffB);
        PG8_WAIT_V(6); PG8_BAR;
    }
    for (;;) {
        const bool has_next = S.next(ui + 1, nxt);
        const char* nA = has_next ? (const char*)g.A + (size_t)nxt.pm * tstepA : cA; const char* nB = has_next ? (const char*)g.Bt + (size_t)nxt.pn * tstepB : cB;
        for (int t = 0; t < nt; t += 2) {
            const bool last = (t == nt - 2);
            const char* a1 = cA + (size_t)(t + 1) * kstep;
            const char* a2 = last ? nA : cA + (size_t)(t + 2) * kstep; const char* b2 = last ? nB : cB + (size_t)(t + 2) * kstep;
            const char* a3 = a2 + kstep; const char* b3 = b2 + kstep;
            if (last && has_next) S.a_ready(nxt);
            if constexpr (SP2) {
            PG8_LDB(B0, 0, 0); PG8_LDB(B1, 0, 1); PG8_SCHED; PG8_LDA(At, 0, 0); PG8_STAGE(PG8_SA(1, 1), a1 + hstepA, voffA);
            PG8_WAIT_V(8); PG8_WAIT_L(0); PG8_BAR; PG8_MMA(0, 0, At, B0); PG8_MMA(0, 1, At, B1); PG8_BAR; PG8_SCHED;
            PG8_LDA(At, 0, 1); PG8_STAGE(PG8_SB(0, 0), b2, voffB); PG8_STAGE(PG8_SB(0, 1), b2 + hstepB, voffB); PG8_STAGE(PG8_SA(0, 0), a2, voffA);
            PG8_WAIT_V(8); PG8_WAIT_L(0); PG8_BAR; PG8_MMA(1, 0, At, B0); PG8_MMA(1, 1, At, B1); PG8_BAR; PG8_SCHED;
            PG8_LDB(B0, 1, 0); PG8_LDB(B1, 1, 1); PG8_SCHED; PG8_LDA(At, 1, 0); PG8_STAGE(PG8_SA(0, 1), a2 + hstepA, voffA);
            PG8_WAIT_V(8); PG8_WAIT_L(0); PG8_BAR; PG8_MMA(0, 0, At, B0); PG8_MMA(0, 1, At, B1); PG8_BAR; PG8_SCHED;
            PG8_LDA(At, 1, 1); PG8_STAGE(PG8_SB(1, 0), b3, voffB); PG8_STAGE(PG8_SB(1, 1), b3 + hstepB, voffB); PG8_STAGE(PG8_SA(1, 0), a3, voffA);
            PG8_WAIT_V(8); PG8_WAIT_L(0); PG8_BAR; PG8_MMA(1, 0, At, B0); PG8_MMA(1, 1, At, B1); PG8_BAR; PG8_SCHED;
            } else {
            PG8_LDB(B0, 0, 0); PG8_SCHED; PG8_LDA(At, 0, 0); PG8_STAGE(PG8_SA(1, 1), a1 + hstepA, voffA);
            PG8_WAIT_L(8); PG8_BAR; PG8_WAIT_L(0); PG8_MMA(0, 0, At, B0); PG8_BAR; PG8_SCHED;
            PG8_LDB(B1, 0, 1); PG8_STAGE(PG8_SB(0, 0), b2, voffB);
            PG8_BAR; PG8_WAIT_L(0); PG8_MMA(0, 1, At, B1); PG8_BAR;
            PG8_LDA(At, 0, 1); PG8_STAGE(PG8_SA(0, 0), a2, voffA);
            PG8_BAR; PG8_WAIT_L(0); PG8_MMA(1, 0, At, B0); PG8_BAR; PG8_SCHED;
            PG8_STAGE(PG8_SB(0, 1), b2 + hstepB, voffB);
            PG8_WAIT_V(6); PG8_BAR; PG8_MMA(1, 1, At, B1); PG8_BAR;
            PG8_LDB(B0, 1, 0); PG8_SCHED; PG8_LDA(At, 1, 0); PG8_STAGE(PG8_SA(0, 1), a2 + hstepA, voffA);
            PG8_WAIT_L(8); PG8_BAR; PG8_WAIT_L(0); PG8_MMA(0, 0, At, B0); PG8_BAR; PG8_SCHED;
            PG8_LDB(B1, 1, 1); PG8_STAGE(PG8_SB(1, 0), b3, voffB);
            PG8_BAR; PG8_WAIT_L(0); PG8_MMA(0, 1, At, B1); PG8_BAR;
            PG8_LDA(At, 1, 1); PG8_STAGE(PG8_SA(1, 0), a3, voffA);
            PG8_BAR; PG8_WAIT_L(0); PG8_MMA(1, 0, At, B0); PG8_BAR; PG8_SCHED;
            PG8_STAGE(PG8_SB(1, 1), b3 + hstepB, voffB);
            PG8_WAIT_V(6); PG8_BAR; PG8_MMA(1, 1, At, B1); PG8_BAR;
            }
        }
        if constexpr (ALIGN_EPI) { if (wr == 0) PG8_BAR; }
        E(acc, cur, wr, wc, fr, fq); S.done(cur);
        if (!has_next) break;
#pragma unroll
        for (int a = 0; a < 2; ++a)
#pragma unroll
            for (int b = 0; b < 2; ++b)
#pragma unroll
                for (int m = 0; m < 4; ++m)
#pragma unroll
                    for (int n = 0; n < 2; ++n) acc[a][b][m][n] = (f32x4){0.f, 0.f, 0.f, 0.f};
        cur = nxt; cA = nA; cB = nB; ++ui;
        if constexpr (ALIGN_EPI) { if (wr == 1) PG8_BAR; }
    }
    PG8_WAIT_V(0);
    if constexpr (!ALIGN_EPI) { if (wr == 0) PG8_BAR; }
    PG8_BAR;
#undef PG8_SA
#undef PG8_SB
#undef PG8_STAGE
#undef PG8_LDA
#undef PG8_LDB
#undef PG8_MMA
#undef PG8_WAIT_V
#undef PG8_WAIT_L
#undef PG8_BAR
#undef PG8_SCHED
}
}

struct Params {
    const float *x_p, *x_s, *cache, *state; const int* ptab;
    const float *a_norm, *a_w_in, *a_v_norm, *a_w_s, *a_b_s, *a_w_out, *mlp_norm, *mlp_w_up, *mlp_w_down, *kv_norm, *w_kv, *cmp_pe, *cmp_w1, *cmp_w2, *k_norm, *b_norm, *b_w_in, *b_q_norm, *b_w_out;
    float* out;
    unsigned* bar;
    bf16 *W_ain, *W_aout, *W_up0, *W_up1, *W_dn0, *W_dn1, *W_kvq, *W_bout, *W_cmp;
    bf16 *XB, *U, *V, *GT, *H1B, *ACT, *H2B, *QN, *KSLC, *KWIN, *VSLCT, *VWINT, *KC, *VCT, *OB, *H3B, *ACMP, *ACMPS;
    float *x_ssq, *v_ssq, *H1, *h1_ssq, *H2, *h2_ssq, *WINF, *QRAW, *GATE, *H3, *h3_ssq, *FCMP, *FCMPS, *ROPE, *CBIAS;
    bf16 *XSB, *GTS, *H1SB, *ACTS, *H2SB, *OSB, *H3SB;
    float *xs_ssq, *US, *VS, *H1S, *h1s_ssq, *H2S, *h2s_ssq, *KVQS, *QS, *GS, *KCS, *VCS, *H3S, *h3s_ssq;
};

__device__ __forceinline__ float row_rs(const float* part, int row, int fq) {
    const GAS f32x4* q = (const GAS f32x4*)(part + (size_t)row * 32 + fq * 8);
    const f32x4 a = q[0], b = q[1];
    float s = ((a.x + a.y) + (a.z + a.w)) + ((b.x + b.y) + (b.z + b.w));
    s += __shfl_xor(s, 16); s += __shfl_xor(s, 32);
    return rsqrtf(s * (1.0f / 2048.0f) + EPS);
}
struct EpiA1 {
    static constexpr bool PERM = true;
    bf16* U; bf16* V; const float* ssq_in; float* vssq;
    __device__ __forceinline__ void operator()(const f32x4 (&acc)[2][2][4][2], const pg8::Unit& u, int wr, int wc, int fr, int fq) const {
        const int row0 = u.pm * 256 + wr * 64 + fr; const bool isv = u.pn >= 8;
        bf16* base = isv ? V : U; const int colt = (isv ? u.pn - 8 : u.pn) * 256 + wc * 32 + 8 * fq;
#pragma unroll
        for (int ai = 0; ai < 2; ++ai)
#pragma unroll
            for (int m = 0; m < 4; ++m) { const int row = row0 + ai * 128 + m * 16; const float rs = row_rs(ssq_in, row, fq); float q = 0.f;
                bf16* rowp = base + (size_t)row * 2048 + colt;
#pragma unroll
                for (int bj = 0; bj < 2; ++bj) { f32x4 v0 = acc[ai][bj][m][0] * rs, v1 = acc[ai][bj][m][1] * rs;
#pragma unroll
                    for (int j = 0; j < 4; ++j) { v0[j] = gelu_t(v0[j]); v1[j] = gelu_t(v1[j]); q += v0[j] * v0[j] + v1[j] * v1[j]; }
                    u32x4 w; w.x = pk2(v0[0], v0[1]); w.y = pk2(v0[2], v0[3]); w.z = pk2(v1[0], v1[1]); w.w = pk2(v1[2], v1[3]);
                    *(GAS u32x4*)(rowp + bj * 128) = w; }
                q += __shfl_xor(q, 16); q += __shfl_xor(q, 32);
                if (isv && fq == 0) vssq[(size_t)row * 32 + (u.pn - 8) * 4 + wc] = q; }
    }
};
struct EpiUp {
    static constexpr bool PERM = true;
    bf16* O; int ldc; const float* ssq_in;
    __device__ __forceinline__ void operator()(const f32x4 (&acc)[2][2][4][2], const pg8::Unit& u, int wr, int wc, int fr, int fq) const {
        const int row0 = u.pm * 256 + wr * 64 + fr; const int colt = u.pn * 256 + wc * 32 + 8 * fq;
#pragma unroll
        for (int ai = 0; ai < 2; ++ai)
#pragma unroll
            for (int m = 0; m < 4; ++m) { const int row = row0 + ai * 128 + m * 16; const float rs = row_rs(ssq_in, row, fq);
                bf16* rowp = O + (size_t)row * ldc + colt;
#pragma unroll
                for (int bj = 0; bj < 2; ++bj) { f32x4 v0 = acc[ai][bj][m][0] * rs, v1 = acc[ai][bj][m][1] * rs;
#pragma unroll
                    for (int j = 0; j < 4; ++j) { const float a = fmaxf(v0[j], 0.f), b = fmaxf(v1[j], 0.f); v0[j] = a * a; v1[j] = b * b; }
                    u32x4 w; w.x = pk2(v0[0], v0[1]); w.y = pk2(v0[2], v0[3]); w.z = pk2(v1[0], v1[1]); w.w = pk2(v1[2], v1[3]);
                    *(GAS u32x4*)(rowp + bj * 128) = w; } }
    }
};
struct EpiRes {
    static constexpr bool PERM = false;
    const float* base; float* out; bf16* ob; float* ssq;
    __device__ __forceinline__ void operator()(const f32x4 (&acc)[2][2][4][2], const pg8::Unit& u, int wr, int wc, int fr, int fq) const {
        const int row0 = u.pm * 256 + wr * 64 + fr, col0 = u.pn * 256 + wc * 32 + 4 * fq;
#pragma unroll
        for (int ai = 0; ai < 2; ++ai)
#pragma unroll
            for (int m = 0; m < 4; ++m) { const int row = row0 + ai * 128 + m * 16; const size_t off = (size_t)row * 2048 + col0; float q = 0.f;
#pragma unroll
                for (int bj = 0; bj < 2; ++bj)
#pragma unroll
                    for (int n = 0; n < 2; ++n) { const f32x4 bs = *(const GAS f32x4*)(base + off + bj * 128 + n * 16); const f32x4 o = bs + acc[ai][bj][m][n];
                        *(GAS f32x4*)(out + off + bj * 128 + n * 16) = o;
                        if (ob) { u32x2 w; w.x = pk2(o[0], o[1]); w.y = pk2(o[2], o[3]); *(GAS u32x2*)(ob + off + bj * 128 + n * 16) = w; }
                        q += (o[0] * o[0] + o[1] * o[1]) + (o[2] * o[2] + o[3] * o[3]); }
                q += __shfl_xor(q, 16); q += __shfl_xor(q, 32);
                if (ssq && fq == 0) ssq[(size_t)row * 32 + u.pn * 4 + wc] = q; }
    }
};
struct EpiKvq {
    static constexpr bool PERM = false;
    float *kvp, *winf, *qraw, *gate; const float* ssq_in;
    __device__ __forceinline__ void operator()(const f32x4 (&acc)[2][2][4][2], const pg8::Unit& u, int wr, int wc, int fr, int fq) const {
        float* base; int ld, c0;
        if (u.pn < 4) { base = kvp; ld = 1024; c0 = u.pn * 256; } else if (u.pn < 6) { base = winf; ld = 512; c0 = (u.pn - 4) * 256; }
        else if (u.pn < 14) { base = qraw; ld = 2048; c0 = (u.pn - 6) * 256; } else { base = gate; ld = 256; c0 = 0; }
        const int row0 = u.pm * 256 + wr * 64 + fr, col0 = c0 + wc * 32 + 4 * fq;
#pragma unroll
        for (int ai = 0; ai < 2; ++ai)
#pragma unroll
            for (int m = 0; m < 4; ++m) { const int row = row0 + ai * 128 + m * 16; const float rs = row_rs(ssq_in, row, fq); float* rowp = base + (size_t)row * ld + col0;
#pragma unroll
                for (int bj = 0; bj < 2; ++bj)
#pragma unroll
                    for (int n = 0; n < 2; ++n) *(GAS f32x4*)(rowp + bj * 128 + n * 16) = acc[ai][bj][m][n] * rs; }
    }
};
struct EpiPlain {
    static constexpr bool PERM = false;
    float* C;
    __device__ __forceinline__ void operator()(const f32x4 (&acc)[2][2][4][2], const pg8::Unit& u, int wr, int wc, int fr, int fq) const {
        const int row0 = u.pm * 256 + wr * 64 + fr, col0 = wc * 32 + 4 * fq;
#pragma unroll
        for (int ai = 0; ai < 2; ++ai)
#pragma unroll
            for (int m = 0; m < 4; ++m) { float* rowp = C + (size_t)(row0 + ai * 128 + m * 16) * 256 + col0;
#pragma unroll
                for (int bj = 0; bj < 2; ++bj)
#pragma unroll
                    for (int n = 0; n < 2; ++n) *(GAS f32x4*)(rowp + bj * 128 + n * 16) = acc[ai][bj][m][n]; }
    }
};

struct SkEpi { int mode; const float* ssq_in; float* f0; float* f1; const float* base; bf16* b0; float* ssq_out; };
__device__ __forceinline__ void skinny_gemm(LAS unsigned char* lds, const bf16* A, int K, const bf16* Bt, int N, const SkEpi e) {
    const int tid = threadIdx.x, wave = tid >> 6, lane = tid & 63, G = gridDim.x;
    if ((int)blockIdx.x >= N / 32) return;
    LAS float* red = (LAS float*)lds;
    LAS float* rst = (LAS float*)(lds + 8 * 32 * 33 * 4);
    if (e.ssq_in) { const int row = tid >> 4, sub = tid & 15; const GAS f32x4* q = (const GAS f32x4*)(e.ssq_in + row * 64 + sub * 4); const f32x4 a = q[0];
        float s = (a.x + a.y) + (a.z + a.w); s += __shfl_xor(s, 1); s += __shfl_xor(s, 2); s += __shfl_xor(s, 4); s += __shfl_xor(s, 8);
        if (sub == 0) rst[row] = rsqrtf(s * (1.0f / 2048.0f) + EPS); }
    else if (tid < 32) rst[tid] = 1.0f;
    __syncthreads();
    const int r = lane & 31, h = lane >> 5, kw = K / 8;
    for (int u = blockIdx.x; u < N / 32; u += G) {
        const int n0 = u * 32;
        const GAS bf16* ap = (const GAS bf16*)A + (size_t)r * K + wave * kw + h * 32;
        const GAS bf16* bp = (const GAS bf16*)Bt + (size_t)(n0 + r) * K + wave * kw + h * 32;
        f32x16 acc;
#pragma unroll
        for (int i = 0; i < 16; ++i) acc[i] = 0.f;
        for (int k = 0; k < kw; k += 64) {
            bf16x8 a[4], b[4];
#pragma unroll
            for (int j = 0; j < 4; ++j) { a[j] = *(const GAS bf16x8*)(ap + k + 8 * j); b[j] = *(const GAS bf16x8*)(bp + k + 8 * j); }
#pragma unroll
            for (int j = 0; j < 4; ++j) acc = __builtin_amdgcn_mfma_f32_32x32x16_bf16(a[j], b[j], acc, 0, 0, 0);
        }
#pragma unroll
        for (int q = 0; q < 16; ++q) red[wave * (32 * 33) + ((q & 3) + 8 * (q >> 2) + 4 * h) * 33 + r] = acc[q];
        __syncthreads();
        const int j = tid & 31, i0 = tid >> 5;
#pragma unroll
        for (int ii = 0; ii < 2; ++ii) { const int i = i0 + 16 * ii; float v = 0.f;
#pragma unroll
            for (int w = 0; w < 8; ++w) v += red[w * (32 * 33) + i * 33 + j];
            const int col = n0 + j; const float rs = rst[i]; float o = 0.f;
            if (e.mode == 0) { e.f0[(size_t)i * N + col] = v * rs; }
            else if (e.mode == 1) { const float z = gelu_t(v * rs); if (col < 2048) e.f0[i * 2048 + col] = z; else e.f1[i * 2048 + col - 2048] = z; }
            else if (e.mode == 2) { o = e.base[(size_t)i * N + col] + v; e.f0[(size_t)i * N + col] = o; if (e.b0) e.b0[(size_t)i * N + col] = (bf16)f2bf(o); }
            else { const float a = fmaxf(v * rs, 0.f); e.b0[(size_t)i * N + col] = (bf16)f2bf(a * a); }
            if (e.mode == 2 && e.ssq_out) { float q = o * o; q += __shfl_xor(q, 1); q += __shfl_xor(q, 2); q += __shfl_xor(q, 4); q += __shfl_xor(q, 8); q += __shfl_xor(q, 16);
                if (j == 0) e.ssq_out[i * 64 + u] = q; } }
        __syncthreads();
    }
}

__device__ __forceinline__ void norm_rope2(float& a, float& b, const float* gain, const float* rope_row, int lane, bool do_rope) {
    const float ss = wave_sum(a * a + b * b); const float r = rsqrtf(ss * (1.0f / 128.0f) + EPS);
    a = a * r * gain[2 * lane]; b = b * r * gain[2 * lane + 1];
    if (do_rope) {
        const float pa = __shfl_xor(a, 8), pb = __shfl_xor(b, 8);
        if (lane < 16) { const int i = 2 * (lane & 7); const float c0 = rope_row[i], c1 = rope_row[i + 1], s0 = rope_row[16 + i], s1 = rope_row[16 + i + 1];
            if (lane < 8) { a = a * c0 - pa * s0; b = b * c1 - pb * s1; } else { a = a * c0 + pa * s0; b = b * c1 + pb * s1; } }
    }
}

__device__ __forceinline__ void transpose_item(const float* W, const float* gain, int K, int Nv, int ldw, bf16* WT, int row_off, int nblk, LAS float* scr, int item, int lane) {
    const int kb = item / nblk, nb = item % nblk, k0 = 64 * kb, n0 = 32 * nb; const int nn = n0 + (lane & 31);
#pragma unroll 8
    for (int i = 0; i < 32; ++i) { const int kk = 2 * i + (lane >> 5); float v = 0.f; if (nn < Nv) { v = W[(size_t)(k0 + kk) * ldw + nn]; if (gain) v *= gain[k0 + kk]; } scr[kk * 33 + (lane & 31)] = v; }
    LDS_WAIT(); asm volatile("" ::: "memory");
    const int c = lane & 7;
#pragma unroll
    for (int j = 0; j < 4; ++j) { const int n = (lane >> 3) + 8 * j; const LAS float* s = scr + (8 * c) * 33 + n;
        u32x4 o; o.x = pk2(s[0 * 33], s[1 * 33]); o.y = pk2(s[2 * 33], s[3 * 33]); o.z = pk2(s[4 * 33], s[5 * 33]); o.w = pk2(s[6 * 33], s[7 * 33]);
        *(GAS u32x4*)(WT + (size_t)(row_off + n0 + n) * K + k0 + 8 * c) = o; }
    LDS_WAIT(); asm volatile("" ::: "memory");
}
__device__ __forceinline__ void row_to_bf16_ssq(const float* xrow, bf16* orow, float* slots, int nslots, int lane) {
    const GAS f32x4* xr = (const GAS f32x4*)xrow + lane; f32x4 v[8]; float s = 0.f;
#pragma unroll
    for (int j = 0; j < 8; ++j) { v[j] = xr[64 * j]; s += (v[j].x * v[j].x + v[j].y * v[j].y) + (v[j].z * v[j].z + v[j].w * v[j].w); }
    s = wave_sum(s);
    GAS unsigned long long* o8 = (GAS unsigned long long*)orow + lane;
#pragma unroll
    for (int j = 0; j < 8; ++j) o8[64 * j] = (unsigned long long)pk2(v[j].x, v[j].y) | ((unsigned long long)pk2(v[j].z, v[j].w) << 32);
    if (lane < nslots) slots[lane] = lane == 0 ? s : 0.f;
}
__device__ __forceinline__ void phase0(const Params& p, LAS unsigned char* lds) {
    const int tid = threadIdx.x, wave = tid >> 6, lane = tid & 63; const int gw = blockIdx.x * 8 + wave, NGW = gridDim.x * 8;
    LAS float* scr = (LAS float*)(lds + wave * 16384);
    constexpr int NITEMS = 4096 + 2048 + 4 * 8192 + 1536 + 2304 + 2048 + 4 * 128;
    for (int it = gw; it < NITEMS; it += NGW) {
        int r = it;
#define TR(W_, g_, WT_, K_, Nv_, ldw_, roff_, nblk_) { const int cnt = ((K_) / 64) * (nblk_); if (r < cnt) { transpose_item(W_, g_, K_, Nv_, ldw_, WT_, roff_, nblk_, scr, r, lane); continue; } r -= cnt; }
        TR(p.a_w_in, p.a_norm, p.W_ain, 2048, 4096, 4096, 0, 128)
        TR(p.a_w_out, nullptr, p.W_aout, 2048, 2048, 2048, 0, 64)
        TR(p.mlp_w_up, p.mlp_norm, p.W_up0, 2048, 8192, 8192, 0, 256)
        TR(p.mlp_w_up + (size_t)2048 * 8192, p.mlp_norm + 2048, p.W_up1, 2048, 8192, 8192, 0, 256)
        TR(p.mlp_w_down, nullptr, p.W_dn0, 8192, 2048, 2048, 0, 64)
        TR(p.mlp_w_down + (size_t)8192 * 2048, nullptr, p.W_dn1, 8192, 2048, 2048, 0, 64)
        TR(p.w_kv, p.kv_norm, p.W_kvq, 2048, 1536, 1536, 0, 48)
        TR(p.b_w_in, p.b_norm, p.W_kvq, 2048, 2096, 2096, 1536, 72)
        TR(p.b_w_out, nullptr, p.W_bout, 2048, 2048, 2048, 0, 64)
        TR(p.cmp_w1, nullptr, p.W_cmp, 2048, 128, 128, 0, 4)
        TR(p.cmp_w1 + (size_t)16 * 128 * 128, nullptr, p.W_cmp, 2048, 128, 128, 128, 4)
        TR(p.cmp_w1 + (size_t)32 * 128 * 128, nullptr, p.W_cmp, 2048, 128, 128, 256, 4)
        TR(p.cmp_w1 + (size_t)48 * 128 * 128, nullptr, p.W_cmp, 2048, 128, 128, 384, 4)
#undef TR
    }
    for (int m = gw; m < MP; m += NGW) row_to_bf16_ssq(p.x_p + (size_t)m * D, p.XB + (size_t)m * D, p.x_ssq + (size_t)m * 32, 32, lane);
    for (int m = gw; m < MS; m += NGW) row_to_bf16_ssq(p.x_s + (size_t)m * D, p.XSB + (size_t)m * D, p.xs_ssq + (size_t)m * 64, 64, lane);
    for (int pos = gw; pos < 8208; pos += NGW) if (lane < 16) {
        const float inv = (float)pow(500000.0, -(double)(2 * lane) / 32.0); const float ang = (float)pos * inv;
        p.ROPE[pos * 32 + lane] = (float)cos((double)ang); p.ROPE[pos * 32 + 16 + lane] = (float)sin((double)ang); }
    for (int it = gw; it < 64; it += NGW) { const float* pe = p.cmp_pe + (size_t)it * 128; const float* w = p.cmp_w1 + (size_t)it * 128 * 128; float a0 = 0.f, a1 = 0.f;
        for (int d = 0; d < 128; ++d) { const float x = pe[d]; a0 += x * w[d * 128 + lane]; a1 += x * w[d * 128 + 64 + lane]; }
        p.CBIAS[it * 128 + lane] = a0; p.CBIAS[it * 128 + 64 + lane] = a1; }
    for (int ri = gw; ri < MS * PASTL; ri += NGW) { const int b = ri >> 13, pos = ri & 8191; const int page = p.ptab[b * NPAGE + (pos >> 7)];
        const GAS f32x4* src = (const GAS f32x4*)(p.cache + ((size_t)page * 128 + (pos & 127)) * 1024 + 8 * lane); const f32x4 v0 = src[0], v1 = src[1];
        const int c = lane >> 5, g = (lane >> 4) & 1, d = (lane & 15) * 8, n = pos >> 4, r = pos & 15;
        u32x4 w; w.x = pk2(v0.x, v0.y); w.y = pk2(v0.z, v0.w); w.z = pk2(v1.x, v1.y); w.w = pk2(v1.z, v1.w);
        *(GAS u32x4*)(p.ACMPS + ((size_t)c * 32768 + (size_t)(b * 2 + g) * 512 + n) * 2048 + r * 128 + d) = w; }
    for (int it = gw; it < MS * 511; it += NGW) { const int b = it / 511, i = it % 511; const GAS f32x4* src = (const GAS f32x4*)(p.state + ((size_t)b * 512 + i + 1) * 512) + lane;
        GAS f32x4* dst = (GAS f32x4*)(p.out + O_WINS + ((size_t)b * 512 + i) * 512) + lane; dst[0] = src[0]; dst[64] = src[64]; }
}

__device__ __forceinline__ void gating_unit(const Params& p, int bi, LAS unsigned char* lds) {
    const int g = bi & 15, m0 = (bi >> 4) * 128, tid = threadIdx.x;
    LAS float* wsl = (LAS float*)lds;
    LAS float* vnl = (LAS float*)(lds + 67584);
    LAS float* rvs = (LAS float*)(lds + 67584 + 65536);
    if (tid < 128) { const float* pp = p.v_ssq + (size_t)(m0 + tid) * 32; float s = 0.f;
#pragma unroll
        for (int k = 0; k < 32; ++k) s += pp[k];
        rvs[tid] = rsqrtf(s * (1.0f / 2048.0f) + EPS); }
    for (int idx = tid; idx < 128 * 128; idx += NT) { const int t = idx >> 7, s = idx & 127; wsl[t * 132 + s] = (s <= t) ? p.a_w_s[(size_t)(g * 128 + t) * 128 + s] : 0.f; }
    __syncthreads();
    for (int idx = tid; idx < 128 * 64; idx += NT) { const int s = idx >> 6, d2 = (idx & 63) * 2; const unsigned w = *(const GAS unsigned*)(p.V + (size_t)(m0 + s) * 2048 + g * 128 + d2);
        const float rv = rvs[s]; vnl[s * 128 + d2] = bf2f(w & 0xffffu) * rv * p.a_v_norm[g * 128 + d2]; vnl[s * 128 + d2 + 1] = bf2f(w >> 16) * rv * p.a_v_norm[g * 128 + d2 + 1]; }
    __syncthreads();
    const int d = tid & 127, tq = tid >> 7;
    for (int k = 0; k < 8; ++k) { const int t0 = (tq + 4 * k) * 4; float a0 = 0.f, a1 = 0.f, a2 = 0.f, a3 = 0.f;
        for (int s = 0; s < t0 + 4; s += 4) {
            const f32x4 w0 = *(const LAS f32x4*)(wsl + (t0 + 0) * 132 + s), w1 = *(const LAS f32x4*)(wsl + (t0 + 1) * 132 + s), w2 = *(const LAS f32x4*)(wsl + (t0 + 2) * 132 + s), w3 = *(const LAS f32x4*)(wsl + (t0 + 3) * 132 + s);
            const float x0 = vnl[(s + 0) * 128 + d], x1 = vnl[(s + 1) * 128 + d], x2 = vnl[(s + 2) * 128 + d], x3 = vnl[(s + 3) * 128 + d];
            a0 += w0.x * x0 + w0.y * x1 + w0.z * x2 + w0.w * x3; a1 += w1.x * x0 + w1.y * x1 + w1.z * x2 + w1.w * x3;
            a2 += w2.x * x0 + w2.y * x1 + w2.z * x2 + w2.w * x3; a3 += w3.x * x0 + w3.y * x1 + w3.z * x2 + w3.w * x3; }
        const float av[4] = {a0, a1, a2, a3};
#pragma unroll
        for (int i = 0; i < 4; ++i) { const int t = t0 + i; const float mixed = av[i] + p.a_b_s[g * 128 + t]; const size_t o = (size_t)(m0 + t) * 2048 + g * 128 + d;
            p.GT[o] = (bf16)f2bf(bf2f(p.U[o]) * mixed); } }
    __syncthreads();
}
__device__ __forceinline__ void sample_gating_row(const Params& p, int i, int lane) {
    const GAS f32x4* vr = (const GAS f32x4*)(p.VS + (size_t)i * 2048) + lane; f32x4 v[8]; float s = 0.f;
#pragma unroll
    for (int j = 0; j < 8; ++j) { v[j] = vr[64 * j]; s += (v[j].x * v[j].x + v[j].y * v[j].y) + (v[j].z * v[j].z + v[j].w * v[j].w); }
    const float rv = rsqrtf(wave_sum(s) * (1.0f / 2048.0f) + EPS);
#pragma unroll
    for (int j = 0; j < 8; ++j) { const int col = 4 * (lane + 64 * j), g = col >> 7; const float w00 = p.a_w_s[(size_t)g * 128 * 128], b0 = p.a_b_s[g * 128];
        const f32x4 gn = *(const GAS f32x4*)(p.a_v_norm + col); const f32x4 vn = v[j] * rv * gn; *(GAS f32x4*)(p.out + O_VAS + (size_t)i * 2048 + col) = vn;
        const f32x4 uu = *(const GAS f32x4*)(p.US + (size_t)i * 2048 + col); const f32x4 o = uu * (vn * w00 + b0);
        u32x2 w; w.x = pk2(o.x, o.y); w.y = pk2(o.z, o.w); *(GAS u32x2*)(p.GTS + (size_t)i * 2048 + col) = w; }
}

__device__ __forceinline__ void cmp_finish(const float* Fk0, const float* Fk1, const float* Fv0, const float* Fv1, const f32x2 bk, const f32x2 bv, const float* w2, const float* knorm0, const float* rope_row, int lane, f32x2& kc, f32x2& vc) {
    const f32x2 fa = *(const GAS f32x2*)(Fk0 + 2 * lane), fb = *(const GAS f32x2*)(Fk1 + 128 + 2 * lane), ga = *(const GAS f32x2*)(Fv0 + 2 * lane), gb = *(const GAS f32x2*)(Fv1 + 128 + 2 * lane);
    const float hk0 = silu_f(fa.x + fb.x + bk.x), hk1 = silu_f(fa.y + fb.y + bk.y), hv0 = silu_f(ga.x + gb.x + bv.x), hv1 = silu_f(ga.y + gb.y + bv.y);
    float k0 = 0.f, k1 = 0.f, v0 = 0.f, v1 = 0.f;
    for (int el = 0; el < 64; ++el) {
        const float ka = __shfl(hk0, el), kb = __shfl(hk1, el), va = __shfl(hv0, el), vb = __shfl(hv1, el);
        const f32x2 wa = *(const GAS f32x2*)(w2 + (size_t)(2 * el) * 128 + 2 * lane), wb = *(const GAS f32x2*)(w2 + (size_t)(2 * el + 1) * 128 + 2 * lane);
        const f32x2 xa = *(const GAS f32x2*)(w2 + 16384 + (size_t)(2 * el) * 128 + 2 * lane), xb = *(const GAS f32x2*)(w2 + 16384 + (size_t)(2 * el + 1) * 128 + 2 * lane);
        k0 += ka * wa.x + kb * wb.x; k1 += ka * wa.y + kb * wb.y; v0 += va * xa.x + vb * xb.x; v1 += va * xa.y + vb * xb.y; }
    norm_rope2(k0, k1, knorm0, rope_row, lane, true);
    kc = (f32x2){k0, k1}; vc = (f32x2){v0, v1};
}
__device__ __forceinline__ void cmp_bias(const Params& p, int lane, f32x2& bk, f32x2& bv) {
    float a0 = 0.f, a1 = 0.f, c0 = 0.f, c1 = 0.f;
    for (int rr = 0; rr < 32; ++rr) { const f32x2 x = *(const GAS f32x2*)(p.CBIAS + rr * 128 + 2 * lane), y = *(const GAS f32x2*)(p.CBIAS + (32 + rr) * 128 + 2 * lane); a0 += x.x; a1 += x.y; c0 += y.x; c1 += y.y; }
    bk = (f32x2){a0, a1}; bv = (f32x2){c0, c1};
}

__device__ __forceinline__ void finish_row_prompt(const Params& p, int m, int lane) {
    const int b = m >> 12, t = m & 4095; const float* rr = p.ROPE + (size_t)t * 32;
    float* kvp = p.out + O_KVP + (size_t)m * 1024; float* wf = p.WINF + (size_t)m * 512;
#pragma unroll
    for (int g = 0; g < 2; ++g) {
        { f32x2 v = *(const GAS f32x2*)(kvp + 512 + g * 128 + 2 * lane); float a = v.x, c = v.y; norm_rope2(a, c, p.k_norm + 128, rr, lane, true);
          *(GAS f32x2*)(kvp + 512 + g * 128 + 2 * lane) = (f32x2){a, c};
          *(GAS unsigned*)(p.KSLC + ((size_t)(b * 2 + g) * 4096 + t) * 128 + 2 * lane) = pk2(a, c); }
        { f32x2 v = *(const GAS f32x2*)(wf + g * 128 + 2 * lane); float a = v.x, c = v.y; norm_rope2(a, c, p.k_norm + 256, rr, lane, true);
          *(GAS f32x2*)(wf + g * 128 + 2 * lane) = (f32x2){a, c};
          *(GAS unsigned*)(p.KWIN + ((size_t)(b * 2 + g) * 4096 + t) * 128 + 2 * lane) = pk2(a, c);
          if (t >= 3584) { float* wo = p.out + O_WINP + ((size_t)b * 512 + (t - 3584)) * 512; *(GAS f32x2*)(wo + g * 128 + 2 * lane) = (f32x2){a, c};
              *(GAS f32x2*)(wo + 256 + g * 128 + 2 * lane) = *(const GAS f32x2*)(wf + 256 + g * 128 + 2 * lane); } }
        { const f32x2 kc = *(const GAS f32x2*)(kvp + g * 128 + 2 * lane), vc = *(const GAS f32x2*)(kvp + 256 + g * 128 + 2 * lane);
          const size_t rowk = (size_t)(b * 2 + g) * 256 + (t >> 4); const int col = (t & 15) * 128 + 2 * lane;
          *(GAS unsigned*)(p.ACMP + rowk * 2048 + col) = pk2(kc.x, kc.y); *(GAS unsigned*)(p.ACMP + (1024 + rowk) * 2048 + col) = pk2(vc.x, vc.y); }
    }
    for (int h = 0; h < 16; ++h) { f32x2 v = *(const GAS f32x2*)(p.QRAW + (size_t)m * 2048 + h * 128 + 2 * lane); float a = v.x, c = v.y; norm_rope2(a, c, p.b_q_norm, rr, lane, true);
        *(GAS unsigned*)(p.QN + (size_t)m * 2048 + h * 128 + 2 * lane) = pk2(a, c); }
}
__device__ __forceinline__ void vt_item(const Params& p, int item, LAS unsigned char* lds) {
    const int tile = item & 63, g = (item >> 6) & 1, b = (item >> 7) & 1, which = item >> 8, tid = threadIdx.x;
    LAS float* tl = (LAS float*)lds;
    const int m0 = b * 4096 + tile * 64;
    for (int idx = tid; idx < 64 * 128; idx += NT) { const int tt = idx >> 7, d = idx & 127;
        tl[tt * 129 + d] = which == 0 ? p.out[O_KVP + (size_t)(m0 + tt) * 1024 + 768 + g * 128 + d] : p.WINF[(size_t)(m0 + tt) * 512 + 256 + g * 128 + d]; }
    __syncthreads();
    bf16* dst = (which == 0 ? p.VSLCT : p.VWINT) + (size_t)((b * 2 + g) * 128) * 4096 + tile * 64;
    for (int idx = tid; idx < 128 * 32; idx += NT) { const int d = idx >> 5, tp = idx & 31; *(GAS unsigned*)(dst + (size_t)d * 4096 + 2 * tp) = pk2(tl[(2 * tp) * 129 + d], tl[(2 * tp + 1) * 129 + d]); }
    __syncthreads();
}
__device__ __forceinline__ void finish_row_sample(const Params& p, int i, int lane) {
    const float* src = p.KVQS + (size_t)i * NKVQ; const float* rr = p.ROPE + (size_t)8192 * 32;
    float* kvs = p.out + O_KVS + (size_t)i * 1024; float* wrow = p.out + O_WINS + ((size_t)i * 512 + 511) * 512;
    for (int ch = 0; ch < 28; ++ch) { f32x2 v = *(const GAS f32x2*)(src + ch * 128 + 2 * lane); float a = v.x, c = v.y;
        if (ch < 12) { const int s = ch >> 1, g = ch & 1;
            if (s == 2) norm_rope2(a, c, p.k_norm + 128, rr, lane, true);
            if (s == 4) norm_rope2(a, c, p.k_norm + 256, rr, lane, true);
            if (s < 4) *(GAS f32x2*)(kvs + s * 256 + g * 128 + 2 * lane) = (f32x2){a, c}; else *(GAS f32x2*)(wrow + (s - 4) * 256 + g * 128 + 2 * lane) = (f32x2){a, c}; }
        else { const int h = ch - 12; norm_rope2(a, c, p.b_q_norm, rr, lane, true); *(GAS f32x2*)(p.QS + (size_t)i * 2048 + h * 128 + 2 * lane) = (f32x2){a, c}; } }
    if (lane < 48) p.GS[i * 48 + lane] = sigmoid_f(src[3584 + lane]);
}

#define MFMA16(a, b, c) __builtin_amdgcn_mfma_f32_16x16x32_bf16(a, b, c, 0, 0, 0)
__device__ __forceinline__ bf16x8 pack_p(const f32x4 a, const f32x4 b) { u32x4 w; w.x = pk2(a[0], a[1]); w.y = pk2(a[2], a[3]); w.z = pk2(b[0], b[1]); w.w = pk2(b[2], b[3]); return __builtin_bit_cast(bf16x8, w); }
constexpr int ATT_SLD = 260;
#define ATT_BLOCK(kb, vtb, ldv, blk0, rowok, tlo, thi, STORE) do { \
    f32x4 s4[2][2]; \
    _Pragma("unroll") for (int pp = 0; pp < 2; ++pp) _Pragma("unroll") for (int hb = 0; hb < 2; ++hb) { f32x4 a_ = {0.f, 0.f, 0.f, 0.f}; \
        const GAS bf16* kp_ = (kb) + (size_t)((blk0) + 32 * pp + 4 * hb + krow) * 128 + 8 * c; \
        _Pragma("unroll") for (int kk = 0; kk < 4; ++kk) a_ = MFMA16(*(const GAS bf16x8*)(kp_ + 32 * kk), qf[kk], a_); s4[pp][hb] = a_; } \
    float bm_ = -1e30f; \
    _Pragma("unroll") for (int pp = 0; pp < 2; ++pp) _Pragma("unroll") for (int hb = 0; hb < 2; ++hb) { _Pragma("unroll") for (int e = 0; e < 4; ++e) { \
        const int kpos_ = (blk0) + 32 * pp + 8 * c + 4 * hb + e; const bool ok_ = (rowok) && kpos_ <= (thi) && kpos_ >= (tlo); \
        const float v_ = ok_ ? s4[pp][hb][e] * SC : -1e30f; s4[pp][hb][e] = v_; bm_ = fmaxf(bm_, v_); } \
        if (STORE) *(LAS f32x4*)(srow + (blk0) + 32 * pp + 8 * c + 4 * hb) = s4[pp][hb]; } \
    bm_ = fmaxf(bm_, __shfl_xor(bm_, 16)); bm_ = fmaxf(bm_, __shfl_xor(bm_, 32)); \
    const float mn_ = fmaxf(m_run, bm_); const float alpha_ = __builtin_amdgcn_exp2f(m_run - mn_); m_run = mn_; float ps_ = 0.f; \
    _Pragma("unroll") for (int pp = 0; pp < 2; ++pp) _Pragma("unroll") for (int hb = 0; hb < 2; ++hb) _Pragma("unroll") for (int e = 0; e < 4; ++e) { \
        const float v_ = s4[pp][hb][e]; const float pv_ = (v_ > -0.5e30f) ? __builtin_amdgcn_exp2f(v_ - mn_) : 0.f; s4[pp][hb][e] = pv_; ps_ += pv_; } \
    l_run = l_run * alpha_ + ps_; \
    _Pragma("unroll") for (int dt = 0; dt < 8; ++dt) oa[dt] *= alpha_; \
    _Pragma("unroll") for (int pp = 0; pp < 2; ++pp) { const bf16x8 pf_ = pack_p(s4[pp][0], s4[pp][1]); \
        _Pragma("unroll") for (int dt = 0; dt < 8; ++dt) oa[dt] = MFMA16(*(const GAS bf16x8*)((vtb) + (size_t)(16 * dt + j) * (ldv) + (blk0) + 32 * pp + 8 * c), pf_, oa[dt]); } \
} while (0)

constexpr int ATT_WAVE_LDS = (16 * ATT_SLD + 32) * 4;
__device__ __forceinline__ void attn_prompt_wave(const Params& p, int b, int g, int t0, LAS float* ps, int lane) {
    const int c = lane >> 4, j = lane & 15, qi = j >> 3, r = j & 7, h = g * 8 + r;
    const int t = t0 + qi, m = b * 4096 + t;
    const float SC = 0.08838834764831845f * 1.4426950408889634f;
    const int krow = 8 * (j >> 2) + (j & 3);
    LAS float* srow = ps + j * ATT_SLD; LAS float* Mrow = ps + 16 * ATT_SLD; LAS float* ILrow = Mrow + 16;
    bf16x8 qf[4];
    { const GAS bf16* qp = (const GAS bf16*)p.QN + (size_t)m * 2048 + h * 128 + 8 * c;
#pragma unroll
      for (int kk = 0; kk < 4; ++kk) qf[kk] = *(const GAS bf16x8*)(qp + 32 * kk); }
    const float g_c = sigmoid_f(p.GATE[(size_t)m * 256 + h * 3 + 0]), g_s = sigmoid_f(p.GATE[(size_t)m * 256 + h * 3 + 1]), g_w = sigmoid_f(p.GATE[(size_t)m * 256 + h * 3 + 2]);
    f32x4 res[8]; f32x4 oa[8]; float m_run, l_run;
    {
        const GAS bf16* kc = (const GAS bf16*)p.KC + (size_t)((b * 2 + g) * 256) * 128;
        const GAS bf16* vct = (const GAS bf16*)p.VCT + (size_t)((b * 2 + g) * 128) * 256;
        const int nvis = (t >= 31) ? ((t - 31) >> 4) + 1 : 0;
#pragma unroll
        for (int dt = 0; dt < 8; ++dt) oa[dt] = (f32x4){0.f, 0.f, 0.f, 0.f};
        m_run = -1e30f; l_run = 0.f;
#pragma unroll 1
        for (int blk = 0; blk < 4; ++blk) { const int blk0 = 64 * blk; ATT_BLOCK(kc, vct, 256, blk0, true, 0, nvis - 1, 1); }
        float lt = l_run; lt += __shfl_xor(lt, 16); lt += __shfl_xor(lt, 32); const float il = lt > 0.f ? 1.0f / lt : 0.f;
        if (c == 0) { Mrow[j] = m_run; ILrow[j] = il; }
        const float f = g_c * il;
#pragma unroll
        for (int dt = 0; dt < 8; ++dt) res[dt] = oa[dt] * f;
    }
    LDS_WAIT(); __builtin_amdgcn_wave_barrier(); asm volatile("" ::: "memory");
    unsigned long long selm0, selm1;
    {
        unsigned long long sm[2];
#pragma unroll
        for (int q2 = 0; q2 < 2; ++q2) { const int tq = t0 + q2, s = lane, cur = tq >> 6; float a = 0.f;
#pragma unroll
            for (int dn = -1; dn <= 3; ++dn) { const int n = 4 * s + dn; if (n >= 0 && n < 255) {
#pragma unroll
                for (int rr = 0; rr < 8; ++rr) { const int row = q2 * 8 + rr; a += __builtin_amdgcn_exp2f(ps[row * ATT_SLD + n] - Mrow[row]) * ILrow[row]; } } }
            const bool causal = s <= cur, forced = (s == 0) || (s == cur) || (s == cur - 1);
            const float score = causal ? a + (forced ? 1e4f : 0.f) : -1e30f; int rank = 0;
#pragma unroll 8
            for (int s2 = 0; s2 < 64; ++s2) { const float v2 = __shfl(score, s2); rank += ((v2 > score) || (v2 == score && s2 < s)) ? 1 : 0; }
            sm[q2] = __ballot(rank < 16 && causal); }
        selm0 = sm[0]; selm1 = sm[1];
    }
    asm volatile("" ::: "memory"); __builtin_amdgcn_wave_barrier();
    {
#pragma unroll
        for (int dt = 0; dt < 8; ++dt) oa[dt] = (f32x4){0.f, 0.f, 0.f, 0.f};
        m_run = -1e30f; l_run = 0.f;
        const unsigned long long mym = qi ? selm1 : selm0; unsigned long long U = selm0 | selm1;
        const GAS bf16* kb = (const GAS bf16*)p.KSLC + (size_t)((b * 2 + g) * 4096) * 128;
        const GAS bf16* vtb = (const GAS bf16*)p.VSLCT + (size_t)((b * 2 + g) * 128) * 4096;
        while (U) { const int s = __builtin_ctzll(U); U &= U - 1; const bool rowsel = (mym >> s) & 1ull; const int blk0 = 64 * s;
            ATT_BLOCK(kb, vtb, 4096, blk0, rowsel, 0, t, 0); }
        float lt = l_run; lt += __shfl_xor(lt, 16); lt += __shfl_xor(lt, 32); const float f = g_s / lt;
#pragma unroll
        for (int dt = 0; dt < 8; ++dt) res[dt] += oa[dt] * f;
    }
    {
#pragma unroll
        for (int dt = 0; dt < 8; ++dt) oa[dt] = (f32x4){0.f, 0.f, 0.f, 0.f};
        m_run = -1e30f; l_run = 0.f;
        const GAS bf16* kb = (const GAS bf16*)p.KWIN + (size_t)((b * 2 + g) * 4096) * 128;
        const GAS bf16* vtb = (const GAS bf16*)p.VWINT + (size_t)((b * 2 + g) * 128) * 4096;
        const int s_lo = (t0 >= 511 ? t0 - 511 : 0) >> 6, s_hi = (t0 + 1) >> 6;
#pragma unroll 1
        for (int s = s_lo; s <= s_hi; ++s) { const int blk0 = 64 * s; ATT_BLOCK(kb, vtb, 4096, blk0, true, t - 511, t, 0); }
        float lt = l_run; lt += __shfl_xor(lt, 16); lt += __shfl_xor(lt, 32); const float f = g_w / lt;
#pragma unroll
        for (int dt = 0; dt < 8; ++dt) res[dt] += oa[dt] * f;
    }
    bf16* op = p.OB + (size_t)m * 2048 + h * 128 + 4 * c;
#pragma unroll
    for (int dt = 0; dt < 8; ++dt) { u32x2 w; w.x = pk2(res[dt][0], res[dt][1]); w.y = pk2(res[dt][2], res[dt][3]); *(GAS u32x2*)(op + 16 * dt) = w; }
    LDS_WAIT(); __builtin_amdgcn_wave_barrier(); asm volatile("" ::: "memory");
}

__device__ __forceinline__ const float* sample_key(const Params& p, int b, int g, int pos, int which  ) {
    if (pos >= PASTL) return p.out + O_KVS + (size_t)b * 1024 + which * 256 + g * 128;
    const int page = p.ptab[b * NPAGE + (pos >> 7)];
    return p.cache + ((size_t)page * 128 + (pos & 127)) * 1024 + which * 256 + g * 128;
}
__device__ __forceinline__ const float* sample_wkey(const Params& p, int b, int g, int jx  , int which  ) {
    if (jx >= 511) return p.out + O_WINS + ((size_t)b * 512 + 511) * 512 + which * 256 + g * 128;
    return p.state + ((size_t)b * 512 + jx + 1) * 512 + which * 256 + g * 128;
}
__device__ __forceinline__ float dot128(const float* kp, const LAS float* q) {
    float a = 0.f;
#pragma unroll 8
    for (int d = 0; d < 128; d += 4) { const f32x4 kv = *(const GAS f32x4*)(kp + d); const f32x4 qv = *(const LAS f32x4*)(q + d); a += (kv.x * qv.x + kv.y * qv.y) + (kv.z * qv.z + kv.w * qv.w); }
    return a;
}
__device__ __forceinline__ void sample_attn(const Params& p, int item, LAS unsigned char* lds) {
    const int b = item >> 1, g = item & 1, tid = threadIdx.x, wave = tid >> 6, lane = tid & 63, h = g * 8 + wave;
    LAS float* qs = (LAS float*)lds;
    LAS float* sc = (LAS float*)(lds + 4096);
    LAS float* imp = (LAS float*)(lds + 4096 + 32768);
    LAS int* flg = (LAS int*)(lds + 4096 + 32768 + 640);
    LAS int* sel = (LAS int*)(lds + 4096 + 32768 + 1280);
    qs[wave * 128 + lane] = p.QS[(size_t)b * 2048 + h * 128 + lane]; qs[wave * 128 + 64 + lane] = p.QS[(size_t)b * 2048 + h * 128 + 64 + lane];
    __syncthreads();
    const LAS float* myq = qs + wave * 128; LAS float* mysc = sc + wave * 1024;
    const float scale = 0.08838834764831845f;
    const float gc = p.GS[b * 48 + h * 3 + 0], gs = p.GS[b * 48 + h * 3 + 1], gw = p.GS[b * 48 + h * 3 + 2];
    float o0 = 0.f, o1 = 0.f;
    { const float* kc = p.KCS + (size_t)((b * 2 + g) * 512) * 128; const float* vc = p.VCS + (size_t)((b * 2 + g) * 512) * 128; float mx = -1e30f;
      for (int k = 0; k < 8; ++k) { const int n = lane + 64 * k; float s = -1e30f; if (n < 511) s = dot128(kc + (size_t)n * 128, myq) * scale; mysc[n] = s; mx = fmaxf(mx, s); }
      mx = wave_max(mx); float sum = 0.f;
      for (int k = 0; k < 8; ++k) { const int n = lane + 64 * k; const float e = (n < 511) ? __expf(mysc[n] - mx) : 0.f; mysc[n] = e; sum += e; }
      sum = wave_sum(sum); const float inv = 1.0f / sum;
      for (int k = 0; k < 8; ++k) { const int n = lane + 64 * k; mysc[n] *= inv; }
      LDS_WAIT(); __builtin_amdgcn_wave_barrier();
      float a0 = 0.f, a1 = 0.f;
      for (int n = 0; n < 511; ++n) { const float pn = mysc[n]; const f32x2 v = *(const GAS f32x2*)(vc + (size_t)n * 128 + 2 * lane); a0 += pn * v.x; a1 += pn * v.y; }
      o0 = gc * a0; o1 = gc * a1; }
    __syncthreads();
    if (tid < 129) { const int s = tid; float a = 0.f;
        for (int dn = -1; dn <= 3; ++dn) { const int n = 4 * s + dn; if (n >= 0 && n < 511) { for (int rr = 0; rr < 8; ++rr) a += sc[rr * 1024 + n]; } }
        const bool forced = (s == 0) || (s == 128) || (s == 127); imp[s] = a + (forced ? 1e4f : 0.f); }
    __syncthreads();
    if (tid < 129) { const float v = imp[tid]; int rank = 0; for (int s2 = 0; s2 < 129; ++s2) { const float v2 = imp[s2]; rank += ((v2 > v) || (v2 == v && s2 < tid)) ? 1 : 0; } flg[tid] = rank < 16 ? 1 : 0; }
    __syncthreads();
    if (tid == 0) { int cnt = 0; for (int s = 0; s < 129; ++s) if (flg[s] && cnt < 16) sel[cnt++] = s; for (; cnt < 16; ++cnt) sel[cnt] = 128; }
    __syncthreads();
    { float mx = -1e30f;
      for (int i = 0; i < 16; ++i) { const int pos = 64 * sel[i] + lane; float s = -1e30f; if (pos <= PASTL) s = dot128(sample_key(p, b, g, pos, 2), myq) * scale; mysc[i * 64 + lane] = s; mx = fmaxf(mx, s); }
      mx = wave_max(mx); float sum = 0.f;
      for (int i = 0; i < 16; ++i) { const float s = mysc[i * 64 + lane]; const float e = (s > -0.5e30f) ? __expf(s - mx) : 0.f; mysc[i * 64 + lane] = e; sum += e; }
      sum = wave_sum(sum); const float inv = 1.0f / sum;
      LDS_WAIT(); __builtin_amdgcn_wave_barrier();
      float a0 = 0.f, a1 = 0.f;
      for (int i = 0; i < 16; ++i) { const int sb = sel[i]; const int nk = (sb == 128) ? 1 : 64;
          for (int kk = 0; kk < nk; ++kk) { const float pn = mysc[i * 64 + kk]; const f32x2 v = *(const GAS f32x2*)(sample_key(p, b, g, 64 * sb + kk, 3) + 2 * lane); a0 += pn * v.x; a1 += pn * v.y; } }
      o0 += gs * inv * a0; o1 += gs * inv * a1; }
    LDS_WAIT(); __builtin_amdgcn_wave_barrier();
    { float mx = -1e30f;
      for (int k = 0; k < 8; ++k) { const int jx = lane + 64 * k; const float s = dot128(sample_wkey(p, b, g, jx, 0), myq) * scale; mysc[jx] = s; mx = fmaxf(mx, s); }
      mx = wave_max(mx); float sum = 0.f;
      for (int k = 0; k < 8; ++k) { const int jx = lane + 64 * k; const float e = __expf(mysc[jx] - mx); mysc[jx] = e; sum += e; }
      sum = wave_sum(sum); const float inv = 1.0f / sum;
      LDS_WAIT(); __builtin_amdgcn_wave_barrier();
      float a0 = 0.f, a1 = 0.f;
      for (int jx = 0; jx < 512; ++jx) { const float pn = mysc[jx]; const f32x2 v = *(const GAS f32x2*)(sample_wkey(p, b, g, jx, 1) + 2 * lane); a0 += pn * v.x; a1 += pn * v.y; }
      o0 += gw * inv * a0; o1 += gw * inv * a1; }
    *(GAS unsigned*)(p.OSB + (size_t)b * 2048 + h * 128 + 2 * lane) = pk2(o0, o1);
    __syncthreads();
}

constexpr int NPHASE = 14;
template <int PH> __device__ __forceinline__ void run_phase(const Params& p, LAS unsigned char* lds) {
    const int tid = threadIdx.x, wave = tid >> 6, lane = tid & 63, G = gridDim.x; const int gw = blockIdx.x * 8 + wave, NGW = G * 8;
    if constexpr (PH == 0) { phase0(p, lds); }
    if constexpr (PH == 1) {
        { pg8::Gemm g{p.XB, p.W_ain, MP, 4096, 2048, 2048, 2048}; pg8::StaticOrder S; S.init(MP, 4096, G, (int)blockIdx.x); EpiA1 E{p.U, p.V, p.x_ssq, p.v_ssq};
          pg8::gemm_phase<EpiA1, pg8::StaticOrder, true, true>(lds, g, S, E); }
        { pg8::Gemm g{p.ACMPS, p.W_cmp, 65536, 512, 2048, 2048, 2048}; pg8::DiagOrder S{256, 128, G, (int)blockIdx.x}; EpiPlain E{p.FCMPS};
          pg8::gemm_phase<EpiPlain, pg8::DiagOrder, true, true>(lds, g, S, E); }
        { SkEpi e{1, p.xs_ssq, p.US, p.VS, nullptr, nullptr, nullptr}; skinny_gemm(lds, p.XSB, 2048, p.W_ain, 4096, e); }
    }
    if constexpr (PH == 2) {
        for (int bi = blockIdx.x; bi < 1024; bi += G) gating_unit(p, bi, lds);
        for (int i = gw; i < MS; i += NGW) sample_gating_row(p, i, lane);
        f32x2 bk, bv; cmp_bias(p, lane, bk, bv);
        for (int it = gw; it < 64 * 511; it += NGW) { const int bg = it / 511, i = it % 511; const size_t r0 = (size_t)bg * 512 + i;
            f32x2 kc, vc; cmp_finish(p.FCMPS + r0 * 256, p.FCMPS + (r0 + 1) * 256, p.FCMPS + (32768 + r0) * 256, p.FCMPS + (32768 + r0 + 1) * 256, bk, bv, p.cmp_w2, p.k_norm, p.ROPE + (size_t)(16 * i + 31) * 32, lane, kc, vc);
            *(GAS f32x2*)(p.KCS + r0 * 128 + 2 * lane) = kc; *(GAS f32x2*)(p.VCS + r0 * 128 + 2 * lane) = vc; }
    }
    if constexpr (PH == 3) {
        { pg8::Gemm g{p.GT, p.W_aout, MP, 2048, 2048, 2048, 2048}; pg8::StaticOrder S; S.init(MP, 2048, G, (int)blockIdx.x); EpiRes E{p.x_p, p.H1, p.H1B, p.h1_ssq};
          pg8::gemm_phase<EpiRes, pg8::StaticOrder, true, true>(lds, g, S, E); }
        { SkEpi e{2, nullptr, p.H1S, nullptr, p.x_s, p.H1SB, p.h1s_ssq}; skinny_gemm(lds, p.GTS, 2048, p.W_aout, 2048, e); }
    }
    if constexpr (PH == 4 || PH == 12) {
        const bool l1 = PH == 12;
        { pg8::Gemm g{l1 ? p.H3B : p.H1B, l1 ? p.W_up1 : p.W_up0, MP, 8192, 2048, 2048, 2048}; pg8::StaticOrder S; S.init(MP, 8192, G, (int)blockIdx.x); EpiUp E{p.ACT, 8192, l1 ? p.h3_ssq : p.h1_ssq};
          pg8::gemm_phase<EpiUp, pg8::StaticOrder, true, true>(lds, g, S, E); }
        { SkEpi e{3, l1 ? p.h3s_ssq : p.h1s_ssq, nullptr, nullptr, nullptr, p.ACTS, nullptr}; skinny_gemm(lds, l1 ? p.H3SB : p.H1SB, 2048, l1 ? p.W_up1 : p.W_up0, 8192, e); }
    }
    if constexpr (PH == 5) {
        { pg8::Gemm g{p.ACT, p.W_dn0, MP, 2048, 8192, 8192, 8192}; pg8::StaticOrder S; S.init(MP, 2048, G, (int)blockIdx.x); EpiRes E{p.H1, p.H2, p.H2B, p.h2_ssq};
          pg8::gemm_phase<EpiRes, pg8::StaticOrder, true, true>(lds, g, S, E); }
        { SkEpi e{2, nullptr, p.H2S, nullptr, p.H1S, p.H2SB, p.h2s_ssq}; skinny_gemm(lds, p.ACTS, 8192, p.W_dn0, 2048, e); }
    }
    if constexpr (PH == 6) {
        { pg8::Gemm g{p.H2B, p.W_kvq, MP, NKVQ, 2048, 2048, 2048}; pg8::StaticOrder S; S.init(MP, NKVQ, G, (int)blockIdx.x); EpiKvq E{p.out + O_KVP, p.WINF, p.QRAW, p.GATE, p.h2_ssq};
          pg8::gemm_phase<EpiKvq, pg8::StaticOrder, true, true>(lds, g, S, E); }
        { SkEpi e{0, p.h2s_ssq, p.KVQS, nullptr, nullptr, nullptr, nullptr}; skinny_gemm(lds, p.H2SB, 2048, p.W_kvq, NKVQ, e); }
    }
    if constexpr (PH == 7) {
        for (int m = gw; m < MP; m += NGW) finish_row_prompt(p, m, lane);
        for (int i = gw; i < MS; i += NGW) finish_row_sample(p, i, lane);
        for (int it = blockIdx.x; it < 512; it += G) vt_item(p, it, lds);
    }
    if constexpr (PH == 8) {
        { pg8::Gemm g{p.ACMP, p.W_cmp, 2048, 512, 2048, 2048, 2048}; pg8::DiagOrder S{8, 4, G, (int)blockIdx.x}; EpiPlain E{p.FCMP};
          pg8::gemm_phase<EpiPlain, pg8::DiagOrder, true, true>(lds, g, S, E); }
        for (int it = (int)blockIdx.x - 8; it >= 0 && it < 64; it += G) sample_attn(p, it, lds);
    }
    if constexpr (PH == 9) {
        f32x2 bk, bv; cmp_bias(p, lane, bk, bv);
        for (int it = gw; it < 4 * 256; it += NGW) { const int bg = it >> 8, i = it & 255; const size_t r0 = (size_t)bg * 256 + i; f32x2 kc = {0.f, 0.f}, vc = {0.f, 0.f};
            if (i < 255) cmp_finish(p.FCMP + r0 * 256, p.FCMP + (r0 + 1) * 256, p.FCMP + (1024 + r0) * 256, p.FCMP + (1024 + r0 + 1) * 256, bk, bv, p.cmp_w2, p.k_norm, p.ROPE + (size_t)(16 * i + 31) * 32, lane, kc, vc);
            *(GAS unsigned*)(p.KC + r0 * 128 + 2 * lane) = pk2(kc.x, kc.y);
            p.VCT[((size_t)bg * 128 + 2 * lane) * 256 + i] = (bf16)f2bf(vc.x); p.VCT[((size_t)bg * 128 + 2 * lane + 1) * 256 + i] = (bf16)f2bf(vc.y); }
    }
    if constexpr (PH == 10) {
        LAS float* ps = (LAS float*)(lds + wave * ATT_WAVE_LDS);
        for (int bi = blockIdx.x; bi < 1024; bi += G) { const int tile = bi >> 2, bg = bi & 3; attn_prompt_wave(p, bg >> 1, bg & 1, tile * 16 + wave * 2, ps, lane); }
    }
    if constexpr (PH == 11) {
        { pg8::Gemm g{p.OB, p.W_bout, MP, 2048, 2048, 2048, 2048}; pg8::StaticOrder S; S.init(MP, 2048, G, (int)blockIdx.x); EpiRes E{p.H2, p.H3, p.H3B, p.h3_ssq};
          pg8::gemm_phase<EpiRes, pg8::StaticOrder, true, true>(lds, g, S, E); }
        { SkEpi e{2, nullptr, p.H3S, nullptr, p.H2S, p.H3SB, p.h3s_ssq}; skinny_gemm(lds, p.OSB, 2048, p.W_bout, 2048, e); }
    }
    if constexpr (PH == 13) {
        { pg8::Gemm g{p.ACT, p.W_dn1, MP, 2048, 8192, 8192, 8192}; pg8::StaticOrder S; S.init(MP, 2048, G, (int)blockIdx.x); EpiRes E{p.H3, p.out + O_YP, nullptr, nullptr};
          pg8::gemm_phase<EpiRes, pg8::StaticOrder, true, true>(lds, g, S, E); }
        { SkEpi e{2, nullptr, p.out + O_YS, nullptr, p.H3S, nullptr, nullptr}; skinny_gemm(lds, p.ACTS, 8192, p.W_dn1, 2048, e); }
    }
}

template <int PH> __global__ void __launch_bounds__(NT, 2) k_phase(Params p) {
    extern __shared__ __attribute__((aligned(16))) unsigned char lds_raw[];
    run_phase<PH>(p, (LAS unsigned char*)lds_raw);
}

template <int PH> static void launch_phase(const Params& p, int grid, hipStream_t stream) {
    static bool attr = false;
    if (!attr) { (void)hipFuncSetAttribute((const void*)k_phase<PH>, hipFuncAttributeMaxDynamicSharedMemorySize, LDS_BYTES); attr = true; }
    hipLaunchKernelGGL(k_phase<PH>, dim3(grid), dim3(NT), LDS_BYTES, stream, p);
}
template <int PH> static void launch_all(const Params& p, int grid, hipStream_t stream) {
    launch_phase<PH>(p, grid, stream);
    if constexpr (PH + 1 < NPHASE) launch_all<PH + 1>(p, grid, stream);
}

extern "C" void kernel_launch(void* const* d_in, const int* in_sizes, int n_in, void* d_out, int out_size, void* d_ws, size_t ws_size, hipStream_t stream) {
    (void)in_sizes; (void)n_in; (void)out_size; (void)ws_size;
    Params p{};
    p.x_p = (const float*)d_in[0]; p.x_s = (const float*)d_in[1]; p.cache = (const float*)d_in[2]; p.state = (const float*)d_in[3]; p.ptab = (const int*)d_in[4];
    p.a_norm = (const float*)d_in[5]; p.a_w_in = (const float*)d_in[6]; p.a_v_norm = (const float*)d_in[7]; p.a_w_s = (const float*)d_in[8]; p.a_b_s = (const float*)d_in[9]; p.a_w_out = (const float*)d_in[10];
    p.mlp_norm = (const float*)d_in[11]; p.mlp_w_up = (const float*)d_in[12]; p.mlp_w_down = (const float*)d_in[13]; p.kv_norm = (const float*)d_in[14]; p.w_kv = (const float*)d_in[15];
    p.cmp_pe = (const float*)d_in[16]; p.cmp_w1 = (const float*)d_in[17]; p.cmp_w2 = (const float*)d_in[18]; p.k_norm = (const float*)d_in[19]; p.b_norm = (const float*)d_in[20];
    p.b_w_in = (const float*)d_in[21]; p.b_q_norm = (const float*)d_in[22]; p.b_w_out = (const float*)d_in[23];
    p.out = (float*)d_out;
    unsigned char* ws = (unsigned char*)d_ws; size_t off = 0;
    auto take = [&](size_t bytes) { unsigned char* r = ws + off; off += (bytes + 4095) & ~(size_t)4095; return r; };
    p.bar = (unsigned*)take(65536);
    p.W_ain = (bf16*)take((size_t)4096 * 2048 * 2); p.W_aout = (bf16*)take((size_t)2048 * 2048 * 2);
    p.W_up0 = (bf16*)take((size_t)8192 * 2048 * 2); p.W_up1 = (bf16*)take((size_t)8192 * 2048 * 2);
    p.W_dn0 = (bf16*)take((size_t)2048 * 8192 * 2); p.W_dn1 = (bf16*)take((size_t)2048 * 8192 * 2);
    p.W_kvq = (bf16*)take((size_t)NKVQ * 2048 * 2); p.W_bout = (bf16*)take((size_t)2048 * 2048 * 2); p.W_cmp = (bf16*)take((size_t)512 * 2048 * 2);
    p.XB = (bf16*)take((size_t)MP * 2048 * 2); p.U = (bf16*)take((size_t)MP * 2048 * 2); p.V = (bf16*)take((size_t)MP * 2048 * 2); p.GT = (bf16*)take((size_t)MP * 2048 * 2);
    p.H1B = (bf16*)take((size_t)MP * 2048 * 2); p.ACT = (bf16*)take((size_t)MP * 8192 * 2); p.H2B = (bf16*)take((size_t)MP * 2048 * 2); p.QN = (bf16*)take((size_t)MP * 2048 * 2);
    p.KSLC = (bf16*)take((size_t)4 * 4096 * 128 * 2); p.KWIN = (bf16*)take((size_t)4 * 4096 * 128 * 2); p.VSLCT = (bf16*)take((size_t)4 * 4096 * 128 * 2); p.VWINT = (bf16*)take((size_t)4 * 4096 * 128 * 2);
    p.KC = (bf16*)take((size_t)4 * 256 * 128 * 2); p.VCT = (bf16*)take((size_t)4 * 256 * 128 * 2); p.OB = (bf16*)take((size_t)MP * 2048 * 2); p.H3B = (bf16*)take((size_t)MP * 2048 * 2);
    p.ACMP = (bf16*)take((size_t)2048 * 2048 * 2); p.ACMPS = (bf16*)take((size_t)65536 * 2048 * 2);
    p.x_ssq = (float*)take((size_t)MP * 32 * 4); p.v_ssq = (float*)take((size_t)MP * 32 * 4); p.H1 = (float*)take((size_t)MP * 2048 * 4); p.h1_ssq = (float*)take((size_t)MP * 32 * 4);
    p.H2 = (float*)take((size_t)MP * 2048 * 4); p.h2_ssq = (float*)take((size_t)MP * 32 * 4); p.WINF = (float*)take((size_t)MP * 512 * 4); p.QRAW = (float*)take((size_t)MP * 2048 * 4);
    p.GATE = (float*)take((size_t)MP * 256 * 4); p.H3 = (float*)take((size_t)MP * 2048 * 4); p.h3_ssq = (float*)take((size_t)MP * 32 * 4);
    p.FCMP = (float*)take((size_t)2048 * 256 * 4); p.FCMPS = (float*)take((size_t)65536 * 256 * 4); p.ROPE = (float*)take((size_t)8208 * 32 * 4); p.CBIAS = (float*)take((size_t)64 * 128 * 4);
    p.XSB = (bf16*)take((size_t)MS * 2048 * 2); p.GTS = (bf16*)take((size_t)MS * 2048 * 2); p.H1SB = (bf16*)take((size_t)MS * 2048 * 2); p.ACTS = (bf16*)take((size_t)MS * 8192 * 2);
    p.H2SB = (bf16*)take((size_t)MS * 2048 * 2); p.OSB = (bf16*)take((size_t)MS * 2048 * 2); p.H3SB = (bf16*)take((size_t)MS * 2048 * 2);
    p.xs_ssq = (float*)take((size_t)MS * 64 * 4); p.US = (float*)take((size_t)MS * 2048 * 4); p.VS = (float*)take((size_t)MS * 2048 * 4); p.H1S = (float*)take((size_t)MS * 2048 * 4); p.h1s_ssq = (float*)take((size_t)MS * 64 * 4);
    p.H2S = (float*)take((size_t)MS * 2048 * 4); p.h2s_ssq = (float*)take((size_t)MS * 64 * 4); p.KVQS = (float*)take((size_t)MS * NKVQ * 4); p.QS = (float*)take((size_t)MS * 2048 * 4); p.GS = (float*)take((size_t)MS * 48 * 4);
    p.KCS = (float*)take((size_t)64 * 512 * 128 * 4); p.VCS = (float*)take((size_t)64 * 512 * 128 * 4); p.H3S = (float*)take((size_t)MS * 2048 * 4); p.h3s_ssq = (float*)take((size_t)MS * 64 * 4);
    static int grid = 0;
    if (grid == 0) { int dev = 0, cus = 0; if (hipGetDevice(&dev) != hipSuccess || hipDeviceGetAttribute(&cus, hipDeviceAttributeMultiprocessorCount, dev) != hipSuccess || cus <= 0) cus = 256; grid = cus; }
    launch_all<0>(p, grid, stream);
}
```

```cpp
#include <hip/hip_runtime.h>
#include <cstdio>
#include <cstdint>

#define GAS __attribute__((address_space(1)))
#define LAS __attribute__((address_space(3)))
typedef unsigned short bf16;
typedef short bf16x8 __attribute__((ext_vector_type(8)));
typedef float f32x4 __attribute__((ext_vector_type(4)));
typedef float f32x2 __attribute__((ext_vector_type(2)));
typedef float f32x16 __attribute__((ext_vector_type(16)));
typedef unsigned u32x4 __attribute__((ext_vector_type(4)));
typedef unsigned u32x2 __attribute__((ext_vector_type(2)));

constexpr int D = 2048, T = 4096, MP = 8192, MS = 32, DFF = 8192, NKVQ = 3840, HD = 128;
constexpr int PASTL = 8192, NPAGE = 64;
constexpr float EPS = 1e-6f;
constexpr size_t O_YP = 0, O_YS = 16777216, O_KVP = 16842752, O_WINP = 25231360, O_KVS = 25755648, O_WINS = 25788416, O_VAS = 34177024;
constexpr int LDS_BYTES = 147456;
constexpr int MISC_OFF = 139264;
constexpr int NT = 512;

__device__ __forceinline__ unsigned f2bf(float f) { unsigned u = __builtin_bit_cast(unsigned, f); return (u + 0x7fffu + ((u >> 16) & 1u)) >> 16; }
__device__ __forceinline__ unsigned pk2(float lo, float hi) { unsigned r; asm("v_cvt_pk_bf16_f32 %0, %1, %2" : "=v"(r) : "v"(lo), "v"(hi)); return r; }
__device__ __forceinline__ float readlane_f(float v, int l) { return __builtin_bit_cast(float, __builtin_amdgcn_readlane(__builtin_bit_cast(int, v), l)); }
__device__ __forceinline__ float bf2f(unsigned b) { return __builtin_bit_cast(float, b << 16); }
__device__ __forceinline__ float wave_sum(float v) {
#pragma unroll
    for (int o = 1; o < 64; o <<= 1) v += __shfl_xor(v, o);
    return v;
}
__device__ __forceinline__ float wave_max(float v) {
#pragma unroll
    for (int o = 1; o < 64; o <<= 1) v = fmaxf(v, __shfl_xor(v, o));
    return v;
}
__device__ __forceinline__ float gelu_t(float x) { const float y2 = (2.0f * 0.7978845608028654f * 1.4426950408889634f) * (x + 0.044715f * x * x * x); const float e = __builtin_amdgcn_exp2f(y2); return x - x * __builtin_amdgcn_rcpf(e + 1.f); }
__device__ __forceinline__ float silu_f(float x) { return x * __builtin_amdgcn_rcpf(1.f + __builtin_amdgcn_exp2f(-1.4426950408889634f * x)); }
__device__ __forceinline__ float sigmoid_f(float x) { return __builtin_amdgcn_rcpf(1.f + __builtin_amdgcn_exp2f(-1.4426950408889634f * x)); }
__device__ __forceinline__ int tid_opaque() { int t = threadIdx.x; asm volatile("" : "+v"(t)); return t; }
#define LDS_WAIT() asm volatile("s_waitcnt lgkmcnt(0)" ::: "memory")
#define VM_WAIT() asm volatile("s_waitcnt vmcnt(0)" ::: "memory")

#define XB_TMO      128
#define XB_XCNT(j)  (256  + 64 * (j))
#define XB_XSUB(j)  (1280 + 64 * (j))
#define XB_XGEN(j)  (2304 + 64 * (j))
#define XB_TOP      3328
#define XB_TOPGEN   3392
#define XCD_BAR_WORDS 3456
#define XB_SPIN_CAP (1u << 18)

__device__ __forceinline__ unsigned xb_ld(unsigned* p)              { return __hip_atomic_load(p, __ATOMIC_RELAXED, __HIP_MEMORY_SCOPE_AGENT); }
__device__ __forceinline__ unsigned xb_add(unsigned* p, unsigned v) { return __hip_atomic_fetch_add(p, v, __ATOMIC_RELAXED, __HIP_MEMORY_SCOPE_AGENT); }
__device__ __forceinline__ unsigned xb_xcc_id() { return (unsigned)__builtin_amdgcn_s_getreg((3 << 11) | 20) & 0xFu; }
#define XB_SPIN(cond, bar) do { unsigned _sp = 0; while (cond) { __builtin_amdgcn_s_sleep(1); \
    if ((++_sp & 255u) == 0u) { if (xb_ld(&(bar)[XB_TMO])) break; if (_sp > XB_SPIN_CAP) { atomicAdd(&(bar)[XB_TMO], 1u); break; } } } } while (0)

struct XcdBarrier {
    unsigned* bar; unsigned x;
    volatile LAS unsigned* st;
};

__device__ __forceinline__ XcdBarrier xcd_barrier_post(unsigned* bar, volatile LAS unsigned* st) {
    XcdBarrier b; b.bar = bar; b.x = xb_xcc_id(); b.st = st;
    if (threadIdx.x == 0) (void)xb_add(&bar[XB_XCNT(b.x)], 1u);
    return b;
}
__device__ __forceinline__ void xcd_barrier_complete(unsigned* bar, unsigned x, unsigned& nloc, unsigned& nx) {
    const unsigned G = gridDim.x * gridDim.y * gridDim.z;
    unsigned sum, cnt, mine, sp = 0u;
    for (;;) {
        sum = 0u; cnt = 0u; mine = 0u;
#pragma unroll
        for (unsigned j = 0; j < 16; ++j) { const unsigned c = xb_ld(&bar[XB_XCNT(j)]); sum += c; cnt += (c > 0u) ? 1u : 0u; mine = (j == x) ? c : mine; }
        if (sum == G) break;
        __builtin_amdgcn_s_sleep(1);
        if ((++sp & 255u) == 0u) { if (xb_ld(&bar[XB_TMO])) break; if (sp > XB_SPIN_CAP) { atomicAdd(&bar[XB_TMO], 1u); break; } }
    }
    nloc = mine > 0u ? mine : 1u; nx = cnt > 0u ? cnt : 1u;
}

__device__ __forceinline__ void xcd_barrier(const XcdBarrier& b) {
    asm volatile("s_waitcnt vmcnt(0)" ::: "memory");
    __syncthreads();
    if (threadIdx.x == 0) {
        unsigned* bar = b.bar;
        __builtin_amdgcn_s_waitcnt(0);
        unsigned nloc = b.st[0], nx = b.st[1];
        if (nloc == 0u) { xcd_barrier_complete(bar, b.x, nloc, nx); b.st[0] = nloc; b.st[1] = nx; }
        const unsigned old = xb_add(&bar[XB_XSUB(b.x)], 1u);
        const unsigned gen = old / nloc;
        if (old + 1u == (gen + 1u) * nloc) {
            __builtin_amdgcn_fence(__ATOMIC_RELEASE, "agent");
            asm volatile("s_waitcnt vmcnt(0)" ::: "memory");
            const unsigned og = xb_add(&bar[XB_TOP], 1u);
            const unsigned tg = og / nx;
            if (og + 1u == (tg + 1u) * nx) xb_add(&bar[XB_TOPGEN], 1u);
            else XB_SPIN(xb_ld(&bar[XB_TOPGEN]) == tg, bar);
            __builtin_amdgcn_fence(__ATOMIC_ACQUIRE, "agent");
            xb_add(&bar[XB_XGEN(b.x)], 1u);
            asm volatile("s_waitcnt vmcnt(0)" ::: "memory");
        } else {
            XB_SPIN(xb_ld(&bar[XB_XGEN(b.x)]) == gen, bar);
            __builtin_amdgcn_fence(__ATOMIC_ACQUIRE, "agent");
            asm volatile("s_waitcnt vmcnt(0)" ::: "memory");
        }
    }
    __syncthreads();
}

namespace pg8 {
#define PG8_LAS __attribute__((address_space(3)))
typedef unsigned short bf16_t;
constexpr int BM = 256, BK = 64, HALF = 128, HTB = HALF * BK * 2  , STAGE_BYTES = 8 * HTB, NXCD = 8, WGM = 8;

__host__ __device__ __forceinline__ int lds_byte(int r, int c) { const int st = (r >> 4) * 2 + (c >> 5), rr = r & 15, cc = c & 31, ob = rr * 64 + cc * 2; return st * 1024 + (ob ^ (((ob >> 9) & 1) << 5)); }
__host__ __device__ __forceinline__ void stage_rc(int b, int& R, int& C) { const int st = b / 1024, sb = b % 1024, swz = sb ^ (((sb >> 9) & 1) << 5); R = (st >> 1) * 16 + swz / 64; C = (st & 1) * 32 + (swz % 64) / 2; }
__host__ __device__ __forceinline__ int perm32(int rho) { const int n = rho >> 4, i = rho & 15; return 8 * (i >> 2) + 4 * n + (i & 3); }

struct Unit { int pm, pn; };
struct Gemm { const bf16_t* A; const bf16_t* Bt; int M, N, K, lda, ldb; };

struct StaticOrder {
    int nM, nN, nwg, G, c;
    __host__ __device__ void init(int M, int N, int G_, int c_) { nM = M / BM; nN = N / BM; nwg = nM * nN; G = G_; c = c_; }
    __host__ __device__ bool next(int i, Unit& u) const {
        const long L = (long)i * G + c; if (L >= nwg) return false;
        int wgid = (int)L; { const int q = nwg / NXCD, r = nwg % NXCD, xcd = wgid % NXCD, off = wgid / NXCD; wgid = (xcd < r ? xcd * (q + 1) : r * (q + 1) + (xcd - r) * q) + off; }
        const int nig = WGM * nN, gid = wgid / nig, fm = gid * WGM, gsz = (nM - fm) < WGM ? (nM - fm) : WGM;
        u.pm = fm + ((wgid % nig) % gsz); u.pn = (wgid % nig) / gsz; return true;
    }
    __device__ __forceinline__ void a_ready(const Unit&) const {}
    __device__ __forceinline__ void done(const Unit&) const {}
};
struct SplitOrder : StaticOrder {
    int nA, perB;
    __device__ __forceinline__ bool next(int i, Unit& u) const {
        long L; if (c >= nA) { if (i >= perB) return false; L = (long)(c - nA) + (long)(G - nA) * i; } else { if (i >= 1) return false; L = (long)perB * (G - nA) + c; }
        if (L >= nwg) return false;
        int wgid = (int)L; { const int q = nwg / NXCD, r = nwg % NXCD, xcd = wgid % NXCD, off = wgid / NXCD; wgid = (xcd < r ? xcd * (q + 1) : r * (q + 1) + (xcd - r) * q) + off; }
        const int nig = WGM * nN, gid = wgid / nig, fm = gid * WGM, gsz = (nM - fm) < WGM ? (nM - fm) : WGM;
        u.pm = fm + ((wgid % nig) % gsz); u.pn = (wgid % nig) / gsz; return true;
    }
};
struct DiagOrder {
    int nunits, per, G, c;
    __device__ __forceinline__ bool next(int i, Unit& u) const { const int L = i * G + c; if (L >= nunits) return false; u.pm = L; u.pn = L / per; return true; }
    __device__ __forceinline__ void a_ready(const Unit&) const {}
    __device__ __forceinline__ void done(const Unit&) const {}
};

template <class Epi, class Sched, bool ALIGN_EPI = false, bool SP2 = false>
__device__ __forceinline__ void gemm_phase(PG8_LAS unsigned char* lds, const Gemm g, const Sched& S, const Epi& E) {
    const int tid = tid_opaque(), wid = __builtin_amdgcn_readfirstlane(tid >> 6), lane = tid & 63, wr = wid >> 2, wc = wid & 3, fr = lane & 15, fq = lane >> 4;
    const int K = g.K, nt = K / BK;
    unsigned voffA[2], voffB[2];
#pragma unroll
    for (int i = 0; i < 2; ++i) { int R, C; stage_rc(tid * 16 + i * 8192, R, C); const int Rb = Epi::PERM ? ((R & ~31) + perm32(R & 31)) : R;
        voffA[i] = (unsigned)(R * g.lda + C) * 2u; voffB[i] = (unsigned)(Rb * g.ldb + C) * 2u; }
    const size_t kstep = (size_t)(BK * 2);
    const size_t hstepA = (size_t)HALF * g.lda * 2, hstepB = (size_t)HALF * g.ldb * 2;
    const size_t tstepA = 2 * hstepA, tstepB = 2 * hstepB;
    const unsigned ldsw = (unsigned)wid * 1024u;
    const int aoff = lds_byte(wr * 64 + fr, fq * 8), boff = lds_byte(wc * 32 + fr, fq * 8);
#define PG8_SA(b, h) (((b) * 2 + (h)) * HTB)
#define PG8_SB(b, h) ((4 + (b) * 2 + (h)) * HTB)
#define PG8_STAGE(bufoff, gbase, voff) do { _Pragma("unroll") for (int _i = 0; _i < 2; ++_i) \
        __builtin_amdgcn_global_load_lds((const unsigned*)((const char*)(gbase) + (voff)[_i]), (PG8_LAS unsigned*)(lds + (bufoff) + ldsw + _i * 8192), 16, 0, 0); } while (0)
#define PG8_LDA(dst, b, h) do { _Pragma("unroll") for (int m = 0; m < 4; ++m) _Pragma("unroll") for (int k = 0; k < 2; ++k) dst[m][k] = *(const PG8_LAS bf16x8*)(lds + PG8_SA(b, h) + aoff + m * 2048 + k * 1024); } while (0)
#define PG8_LDB(dst, b, h) do { _Pragma("unroll") for (int n = 0; n < 2; ++n) _Pragma("unroll") for (int k = 0; k < 2; ++k) dst[n][k] = *(const PG8_LAS bf16x8*)(lds + PG8_SB(b, h) + boff + n * 2048 + k * 1024); } while (0)
#define PG8_MMA(ai, bj, At, Bt) do { __builtin_amdgcn_s_setprio(1); _Pragma("unroll") for (int m = 0; m < 4; ++m) _Pragma("unroll") for (int n = 0; n < 2; ++n) _Pragma("unroll") for (int k = 0; k < 2; ++k) \
        acc[ai][bj][m][n] = __builtin_amdgcn_mfma_f32_16x16x32_bf16(Bt[n][k], At[m][k], acc[ai][bj][m][n], 0, 0, 0); __builtin_amdgcn_s_setprio(0); } while (0)
#define PG8_WAIT_V(n) asm volatile("s_waitcnt vmcnt(" #n ")" ::: "memory")
#define PG8_WAIT_L(n) asm volatile("s_waitcnt lgkmcnt(" #n ")" ::: "memory")
#define PG8_BAR __builtin_amdgcn_s_barrier()
#define PG8_SCHED __builtin_amdgcn_sched_barrier(0)
    Unit cur, nxt; int ui = 0;
    if (!S.next(0, cur)) return;
    f32x4 acc[2][2][4][2];
    E.init(acc, cur, wr, wc, fr, fq);
    bf16x8 At[4][2], B0[2][2], B1[2][2];
    const char* cA = (const char*)g.A + (size_t)cur.pm * tstepA; const char* cB = (const char*)g.Bt + (size_t)cur.pn * tstepB;
    S.a_ready(cur);
    if constexpr (SP2) {
        PG8_STAGE(PG8_SB(0, 0), cB, voffB); PG8_STAGE(PG8_SB(0, 1), cB + hstepB, voffB); PG8_STAGE(PG8_SA(0, 0), cA, voffA); PG8_STAGE(PG8_SA(0, 1), cA + hstepA, voffA);
        if (wr == 1) PG8_BAR;
        PG8_WAIT_V(2); PG8_BAR;
        PG8_STAGE(PG8_SB(1, 0), cB + kstep, voffB); PG8_STAGE(PG8_SA(1, 0), cA + kstep, voffA); PG8_STAGE(PG8_SB(1, 1), cB + hstepB + kstep, voffB);
        PG8_WAIT_V(6); PG8_BAR;
    } else {
        PG8_STAGE(PG8_SB(0, 0), cB, voffB); PG8_STAGE(PG8_SA(0, 0), cA, voffA); PG8_STAGE(PG8_SB(0, 1), cB + hstepB, voffB); PG8_STAGE(PG8_SA(0, 1), cA + hstepA, voffA);
        if (wr == 1) PG8_BAR;
        PG8_WAIT_V(4); PG8_BAR;
        PG8_STAGE(PG8_SB(1, 0), cB + kstep, voffB); PG8_STAGE(PG8_SA(1, 0), cA + kstep, voffA); PG8_STAGE(PG8_SB(1, 1), cB + hstepB + kstep, voffB);
        PG8_WAIT_V(6); PG8_BAR;
    }
    for (;;) {
        const bool has_next = S.next(ui + 1, nxt);
        const char* nA = has_next ? (const char*)g.A + (size_t)nxt.pm * tstepA : cA; const char* nB = has_next ? (const char*)g.Bt + (size_t)nxt.pn * tstepB : cB;
        for (int t = 0; t < nt; t += 2) {
            const bool last = (t == nt - 2);
            const char* a1 = cA + (size_t)(t + 1) * kstep;
            const char* a2 = last ? nA : cA + (size_t)(t + 2) * kstep; const char* b2 = last ? nB : cB + (size_t)(t + 2) * kstep;
            const char* a3 = a2 + kstep; const char* b3 = b2 + kstep;
            if (last && has_next) S.a_ready(nxt);
            if constexpr (SP2) {
            PG8_LDB(B0, 0, 0); PG8_LDB(B1, 0, 1); PG8_SCHED; PG8_LDA(At, 0, 0); PG8_STAGE(PG8_SA(1, 1), a1 + hstepA, voffA);
            PG8_WAIT_V(8); PG8_WAIT_L(0); PG8_BAR; PG8_MMA(0, 0, At, B0); PG8_MMA(0, 1, At, B1); PG8_BAR; PG8_SCHED;
            PG8_LDA(At, 0, 1); PG8_STAGE(PG8_SB(0, 0), b2, voffB); PG8_STAGE(PG8_SB(0, 1), b2 + hstepB, voffB); PG8_STAGE(PG8_SA(0, 0), a2, voffA);
            PG8_WAIT_V(8); PG8_WAIT_L(0); PG8_BAR; PG8_MMA(1, 0, At, B0); PG8_MMA(1, 1, At, B1); PG8_BAR; PG8_SCHED;
            PG8_LDB(B0, 1, 0); PG8_LDB(B1, 1, 1); PG8_SCHED; PG8_LDA(At, 1, 0); PG8_STAGE(PG8_SA(0, 1), a2 + hstepA, voffA);
            PG8_WAIT_V(8); PG8_WAIT_L(0); PG8_BAR; PG8_MMA(0, 0, At, B0); PG8_MMA(0, 1, At, B1); PG8_BAR; PG8_SCHED;
            PG8_LDA(At, 1, 1); PG8_STAGE(PG8_SB(1, 0), b3, voffB); PG8_STAGE(PG8_SB(1, 1), b3 + hstepB, voffB); PG8_STAGE(PG8_SA(1, 0), a3, voffA);
            PG8_WAIT_V(8); PG8_WAIT_L(0); PG8_BAR; PG8_MMA(1, 0, At, B0); PG8_MMA(1, 1, At, B1); PG8_BAR; PG8_SCHED;
            } else {
            PG8_LDB(B0, 0, 0); PG8_SCHED; PG8_LDA(At, 0, 0); PG8_STAGE(PG8_SA(1, 1), a1 + hstepA, voffA);
            PG8_WAIT_L(8); PG8_BAR; PG8_WAIT_L(0); PG8_MMA(0, 0, At, B0); PG8_BAR; PG8_SCHED;
            PG8_LDB(B1, 0, 1); PG8_STAGE(PG8_SB(0, 0), b2, voffB);
            PG8_BAR; PG8_WAIT_L(0); PG8_MMA(0, 1, At, B1); PG8_BAR;
            PG8_LDA(At, 0, 1); PG8_STAGE(PG8_SA(0, 0), a2, voffA);
            PG8_BAR; PG8_WAIT_L(0); PG8_MMA(1, 0, At, B0); PG8_BAR; PG8_SCHED;
            PG8_STAGE(PG8_SB(0, 1), b2 + hstepB, voffB);
            PG8_WAIT_V(6); PG8_BAR; PG8_MMA(1, 1, At, B1); PG8_BAR;
            PG8_LDB(B0, 1, 0); PG8_SCHED; PG8_LDA(At, 1, 0); PG8_STAGE(PG8_SA(0, 1), a2 + hstepA, voffA);
            PG8_WAIT_L(8); PG8_BAR; PG8_WAIT_L(0); PG8_MMA(0, 0, At, B0); PG8_BAR; PG8_SCHED;
            PG8_LDB(B1, 1, 1); PG8_STAGE(PG8_SB(1, 0), b3, voffB);
            PG8_BAR; PG8_WAIT_L(0); PG8_MMA(0, 1, At, B1); PG8_BAR;
            PG8_LDA(At, 1, 1); PG8_STAGE(PG8_SA(1, 0), a3, voffA);
            PG8_BAR; PG8_WAIT_L(0); PG8_MMA(1, 0, At, B0); PG8_BAR; PG8_SCHED;
            PG8_STAGE(PG8_SB(1, 1), b3 + hstepB, voffB);
            PG8_WAIT_V(6); PG8_BAR; PG8_MMA(1, 1, At, B1); PG8_BAR;
            }
        }
        if constexpr (ALIGN_EPI) { if (wr == 0) PG8_BAR; }
        E(acc, cur, wr, wc, fr, fq); S.done(cur);
        if (!has_next) break;
        E.init(acc, nxt, wr, wc, fr, fq);
        cur = nxt; cA = nA; cB = nB; ++ui;
        if constexpr (ALIGN_EPI) { if (wr == 1) PG8_BAR; }
    }
    PG8_WAIT_V(0);
    if constexpr (!ALIGN_EPI) { if (wr == 0) PG8_BAR; }
    PG8_BAR;
#undef PG8_SA
#undef PG8_SB
#undef PG8_STAGE
#undef PG8_LDA
#undef PG8_LDB
#undef PG8_MMA
#undef PG8_WAIT_V
#undef PG8_WAIT_L
#undef PG8_BAR
#undef PG8_SCHED
}
}

struct Params {
    const void* in[24]; float* out; unsigned char* ws;
    __device__ __forceinline__ const float* x_p() const { return (const float*)in[0]; }
    __device__ __forceinline__ const float* x_s() const { return (const float*)in[1]; }
    __device__ __forceinline__ const float* cache() const { return (const float*)in[2]; }
    __device__ __forceinline__ const float* state() const { return (const float*)in[3]; }
    __device__ __forceinline__ const int* ptab() const { return (const int*)in[4]; }
    __device__ __forceinline__ const float* a_norm() const { return (const float*)in[5]; }
    __device__ __forceinline__ const float* a_w_in() const { return (const float*)in[6]; }
    __device__ __forceinline__ const float* a_v_norm() const { return (const float*)in[7]; }
    __device__ __forceinline__ const float* a_w_s() const { return (const float*)in[8]; }
    __device__ __forceinline__ const float* a_b_s() const { return (const float*)in[9]; }
    __device__ __forceinline__ const float* a_w_out() const { return (const float*)in[10]; }
    __device__ __forceinline__ const float* mlp_norm() const { return (const float*)in[11]; }
    __device__ __forceinline__ const float* mlp_w_up() const { return (const float*)in[12]; }
    __device__ __forceinline__ const float* mlp_w_down() const { return (const float*)in[13]; }
    __device__ __forceinline__ const float* kv_norm() const { return (const float*)in[14]; }
    __device__ __forceinline__ const float* w_kv() const { return (const float*)in[15]; }
    __device__ __forceinline__ const float* cmp_pe() const { return (const float*)in[16]; }
    __device__ __forceinline__ const float* cmp_w1() const { return (const float*)in[17]; }
    __device__ __forceinline__ const float* cmp_w2() const { return (const float*)in[18]; }
    __device__ __forceinline__ const float* k_norm() const { return (const float*)in[19]; }
    __device__ __forceinline__ const float* b_norm() const { return (const float*)in[20]; }
    __device__ __forceinline__ const float* b_w_in() const { return (const float*)in[21]; }
    __device__ __forceinline__ const float* b_q_norm() const { return (const float*)in[22]; }
    __device__ __forceinline__ const float* b_w_out() const { return (const float*)in[23]; }
    __device__ __forceinline__ unsigned* bar() const { return (unsigned*)(ws + 0ull); }
    __device__ __forceinline__ bf16* W_ain() const { return (bf16*)(ws + 65536ull); }
    __device__ __forceinline__ bf16* W_aout() const { return (bf16*)(ws + 16842752ull); }
    __device__ __forceinline__ bf16* W_up0() const { return (bf16*)(ws + 25231360ull); }
    __device__ __forceinline__ bf16* W_up1() const { return (bf16*)(ws + 58785792ull); }
    __device__ __forceinline__ bf16* W_dn0() const { return (bf16*)(ws + 92340224ull); }
    __device__ __forceinline__ bf16* W_dn1() const { return (bf16*)(ws + 125894656ull); }
    __device__ __forceinline__ bf16* W_kvq() const { return (bf16*)(ws + 159449088ull); }
    __device__ __forceinline__ bf16* W_bout() const { return (bf16*)(ws + 175177728ull); }
    __device__ __forceinline__ bf16* W_cmp() const { return (bf16*)(ws + 183566336ull); }
    __device__ __forceinline__ bf16* XB() const { return (bf16*)(ws + 185663488ull); }
    __device__ __forceinline__ bf16* U() const { return (bf16*)(ws + 219217920ull); }
    __device__ __forceinline__ bf16* V() const { return (bf16*)(ws + 252772352ull); }
    __device__ __forceinline__ bf16* GT() const { return (bf16*)(ws + 286326784ull); }
    __device__ __forceinline__ bf16* H1B() const { return (bf16*)(ws + 319881216ull); }
    __device__ __forceinline__ bf16* ACT() const { return (bf16*)(ws + 353435648ull); }
    __device__ __forceinline__ bf16* H2B() const { return (bf16*)(ws + 487653376ull); }
    __device__ __forceinline__ bf16* QN() const { return (bf16*)(ws + 521207808ull); }
    __device__ __forceinline__ bf16* KSLC() const { return (bf16*)(ws + 554762240ull); }
    __device__ __forceinline__ bf16* KWIN() const { return (bf16*)(ws + 558956544ull); }
    __device__ __forceinline__ bf16* VSLCT() const { return (bf16*)(ws + 563150848ull); }
    __device__ __forceinline__ bf16* VWINT() const { return (bf16*)(ws + 567345152ull); }
    __device__ __forceinline__ bf16* KC() const { return (bf16*)(ws + 571539456ull); }
    __device__ __forceinline__ bf16* VCT() const { return (bf16*)(ws + 571801600ull); }
    __device__ __forceinline__ bf16* OB() const { return (bf16*)(ws + 572063744ull); }
    __device__ __forceinline__ bf16* H3B() const { return (bf16*)(ws + 605618176ull); }
    __device__ __forceinline__ bf16* ACMP() const { return (bf16*)(ws + 639172608ull); }
    __device__ __forceinline__ bf16* ACMPS() const { return (bf16*)(ws + 647561216ull); }
    __device__ __forceinline__ float* x_ssq() const { return (float*)(ws + 915996672ull); }
    __device__ __forceinline__ float* v_ssq() const { return (float*)(ws + 917045248ull); }
    __device__ __forceinline__ float* H1() const { return (float*)(ws + 918093824ull); }
    __device__ __forceinline__ float* h1_ssq() const { return (float*)(ws + 985202688ull); }
    __device__ __forceinline__ float* H2() const { return (float*)(ws + 986251264ull); }
    __device__ __forceinline__ float* h2_ssq() const { return (float*)(ws + 1053360128ull); }
    __device__ __forceinline__ float* WINF() const { return (float*)(ws + 1054408704ull); }
    __device__ __forceinline__ float* QRAW() const { return (float*)(ws + 1071185920ull); }
    __device__ __forceinline__ float* GATE() const { return (float*)(ws + 1138294784ull); }
    __device__ __forceinline__ float* H3() const { return (float*)(ws + 1146683392ull); }
    __device__ __forceinline__ float* h3_ssq() const { return (float*)(ws + 1213792256ull); }
    __device__ __forceinline__ float* FCMP() const { return (float*)(ws + 1214840832ull); }
    __device__ __forceinline__ float* FCMPS() const { return (float*)(ws + 1216937984ull); }
    __device__ __forceinline__ float* ROPE() const { return (float*)(ws + 1284046848ull); }
    __device__ __forceinline__ float* CBIAS() const { return (float*)(ws + 1285099520ull); }
    __device__ __forceinline__ bf16* XSB() const { return (bf16*)(ws + 1285132288ull); }
    __device__ __forceinline__ bf16* GTS() const { return (bf16*)(ws + 1285263360ull); }
    __device__ __forceinline__ bf16* H1SB() const { return (bf16*)(ws + 1285394432ull); }
    __device__ __forceinline__ bf16* ACTS() const { return (bf16*)(ws + 1285525504ull); }
    __device__ __forceinline__ bf16* H2SB() const { return (bf16*)(ws + 1286049792ull); }
    __device__ __forceinline__ bf16* OSB() const { return (bf16*)(ws + 1286180864ull); }
    __device__ __forceinline__ bf16* H3SB() const { return (bf16*)(ws + 1286311936ull); }
    __device__ __forceinline__ float* xs_ssq() const { return (float*)(ws + 1286443008ull); }
    __device__ __forceinline__ float* US() const { return (float*)(ws + 1286451200ull); }
    __device__ __forceinline__ float* VS() const { return (float*)(ws + 1286713344ull); }
    __device__ __forceinline__ float* H1S() const { return (float*)(ws + 1286975488ull); }
    __device__ __forceinline__ float* h1s_ssq() const { return (float*)(ws + 1287237632ull); }
    __device__ __forceinline__ float* H2S() const { return (float*)(ws + 1287245824ull); }
    __device__ __forceinline__ float* h2s_ssq() const { return (float*)(ws + 1287507968ull); }
    __device__ __forceinline__ float* KVQS() const { return (float*)(ws + 1287516160ull); }
    __device__ __forceinline__ float* QS() const { return (float*)(ws + 1288007680ull); }
    __device__ __forceinline__ float* GS() const { return (float*)(ws + 1288269824ull); }
    __device__ __forceinline__ float* KCS() const { return (float*)(ws + 1288278016ull); }
    __device__ __forceinline__ float* VCS() const { return (float*)(ws + 1305055232ull); }
    __device__ __forceinline__ float* H3S() const { return (float*)(ws + 1321832448ull); }
    __device__ __forceinline__ float* h3s_ssq() const { return (float*)(ws + 1322094592ull); }
    __device__ __forceinline__ float* OSFC() const { return (float*)(ws + 1322102784ull); }
    __device__ __forceinline__ float* OSFW() const { return (float*)(ws + 1322364928ull); }
    __device__ __forceinline__ int* SELG() const { return (int*)(ws + 1322627072ull); }
    __device__ __forceinline__ float* FCMP8() const { return (float*)(ws + 1322631168ull); }
    __device__ __forceinline__ float* CBIASF() const { return (float*)(ws + 1339408384ull); }
};
constexpr size_t WS_TOTAL = 1339412480ull;

__device__ __forceinline__ float row_rs(const float* part, int row, int fq) {
    const GAS f32x4* q = (const GAS f32x4*)(part + (size_t)row * 32 + fq * 8);
    const f32x4 a = q[0], b = q[1];
    float s = ((a.x + a.y) + (a.z + a.w)) + ((b.x + b.y) + (b.z + b.w));
    s += __shfl_xor(s, 16); s += __shfl_xor(s, 32);
    return rsqrtf(s * (1.0f / 2048.0f) + EPS);
}
struct EpiA1 {
    static constexpr bool PERM = true;
    bf16* U; bf16* V; const float* ssq_in; float* vssq;
    __device__ __forceinline__ void init(f32x4 (&acc)[2][2][4][2], const pg8::Unit&, int, int, int, int) const {
#pragma unroll
        for (int a = 0; a < 2; ++a)
#pragma unroll
            for (int b = 0; b < 2; ++b)
#pragma unroll
                for (int m = 0; m < 4; ++m)
#pragma unroll
                    for (int n = 0; n < 2; ++n) acc[a][b][m][n] = (f32x4){0.f, 0.f, 0.f, 0.f}; }
    __device__ __forceinline__ void operator()(const f32x4 (&acc)[2][2][4][2], const pg8::Unit& u, int wr, int wc, int fr, int fq) const {
        const int row0 = u.pm * 256 + wr * 64 + fr; const bool isv = u.pn >= 8;
        bf16* base = isv ? V : U; const int colt = (isv ? u.pn - 8 : u.pn) * 256 + wc * 32 + 8 * fq;
#pragma unroll
        for (int ai = 0; ai < 2; ++ai)
#pragma unroll
            for (int m = 0; m < 4; ++m) { const int row = row0 + ai * 128 + m * 16; const float rs = row_rs(ssq_in, row, fq); float q = 0.f;
                bf16* rowp = base + (size_t)row * 2048 + colt;
#pragma unroll
                for (int bj = 0; bj < 2; ++bj) { f32x4 v0 = acc[ai][bj][m][0] * rs, v1 = acc[ai][bj][m][1] * rs;
#pragma unroll
                    for (int j = 0; j < 4; ++j) { v0[j] = gelu_t(v0[j]); v1[j] = gelu_t(v1[j]); q += v0[j] * v0[j] + v1[j] * v1[j]; }
                    u32x4 w; w.x = pk2(v0[0], v0[1]); w.y = pk2(v0[2], v0[3]); w.z = pk2(v1[0], v1[1]); w.w = pk2(v1[2], v1[3]);
                    *(GAS u32x4*)(rowp + bj * 128) = w; }
                q += __shfl_xor(q, 16); q += __shfl_xor(q, 32);
                if (isv && fq == 0) vssq[(size_t)row * 32 + (u.pn - 8) * 4 + wc] = q; }
    }
};
struct EpiUp {
    static constexpr bool PERM = true;
    bf16* O; int ldc; const float* ssq_in;
    __device__ __forceinline__ void init(f32x4 (&acc)[2][2][4][2], const pg8::Unit&, int, int, int, int) const {
#pragma unroll
        for (int a = 0; a < 2; ++a)
#pragma unroll
            for (int b = 0; b < 2; ++b)
#pragma unroll
                for (int m = 0; m < 4; ++m)
#pragma unroll
                    for (int n = 0; n < 2; ++n) acc[a][b][m][n] = (f32x4){0.f, 0.f, 0.f, 0.f}; }
    __device__ __forceinline__ void operator()(const f32x4 (&acc)[2][2][4][2], const pg8::Unit& u, int wr, int wc, int fr, int fq) const {
        const int row0 = u.pm * 256 + wr * 64 + fr; const int colt = u.pn * 256 + wc * 32 + 8 * fq;
#pragma unroll
        for (int ai = 0; ai < 2; ++ai)
#pragma unroll
            for (int m = 0; m < 4; ++m) { const int row = row0 + ai * 128 + m * 16; const float rs = row_rs(ssq_in, row, fq);
                bf16* rowp = O + (size_t)row * ldc + colt;
#pragma unroll
                for (int bj = 0; bj < 2; ++bj) { f32x4 v0 = acc[ai][bj][m][0] * rs, v1 = acc[ai][bj][m][1] * rs;
#pragma unroll
                    for (int j = 0; j < 4; ++j) { const float a = fmaxf(v0[j], 0.f), b = fmaxf(v1[j], 0.f); v0[j] = a * a; v1[j] = b * b; }
                    u32x4 w; w.x = pk2(v0[0], v0[1]); w.y = pk2(v0[2], v0[3]); w.z = pk2(v1[0], v1[1]); w.w = pk2(v1[2], v1[3]);
                    *(GAS u32x4*)(rowp + bj * 128) = w; } }
    }
};
struct EpiRes {
    static constexpr bool PERM = false;
    const float* base; float* out; bf16* ob; float* ssq;
    __device__ __forceinline__ void init(f32x4 (&acc)[2][2][4][2], const pg8::Unit& u, int wr, int wc, int fr, int fq) const {
        const int row0 = u.pm * 256 + wr * 64 + fr, col0 = u.pn * 256 + wc * 32 + 4 * fq;
#pragma unroll
        for (int ai = 0; ai < 2; ++ai)
#pragma unroll
            for (int m = 0; m < 4; ++m) { const size_t off = (size_t)(row0 + ai * 128 + m * 16) * 2048 + col0;
#pragma unroll
                for (int bj = 0; bj < 2; ++bj)
#pragma unroll
                    for (int n = 0; n < 2; ++n) acc[ai][bj][m][n] = *(const GAS f32x4*)(base + off + bj * 128 + n * 16); } }
    __device__ __forceinline__ void operator()(const f32x4 (&acc)[2][2][4][2], const pg8::Unit& u, int wr, int wc, int fr, int fq) const {
        const int row0 = u.pm * 256 + wr * 64 + fr, col0 = u.pn * 256 + wc * 32 + 4 * fq;
#pragma unroll
        for (int ai = 0; ai < 2; ++ai)
#pragma unroll
            for (int m = 0; m < 4; ++m) { const int row = row0 + ai * 128 + m * 16; const size_t off = (size_t)row * 2048 + col0; float q = 0.f;
#pragma unroll
                for (int bj = 0; bj < 2; ++bj)
#pragma unroll
                    for (int n = 0; n < 2; ++n) { const f32x4 o = acc[ai][bj][m][n];
                        *(GAS f32x4*)(out + off + bj * 128 + n * 16) = o;
                        if (ob) { u32x2 w; w.x = pk2(o[0], o[1]); w.y = pk2(o[2], o[3]); *(GAS u32x2*)(ob + off + bj * 128 + n * 16) = w; }
                        q += (o[0] * o[0] + o[1] * o[1]) + (o[2] * o[2] + o[3] * o[3]); }
                q += __shfl_xor(q, 16); q += __shfl_xor(q, 32);
                if (ssq && fq == 0) ssq[(size_t)row * 32 + u.pn * 4 + wc] = q; }
    }
};
struct EpiKvq {
    static constexpr bool PERM = false;
    float *kvp, *winf, *qraw, *gate; const float* ssq_in; bf16* acmp;
    __device__ __forceinline__ void init(f32x4 (&acc)[2][2][4][2], const pg8::Unit&, int, int, int, int) const {
#pragma unroll
        for (int a = 0; a < 2; ++a)
#pragma unroll
            for (int b = 0; b < 2; ++b)
#pragma unroll
                for (int m = 0; m < 4; ++m)
#pragma unroll
                    for (int n = 0; n < 2; ++n) acc[a][b][m][n] = (f32x4){0.f, 0.f, 0.f, 0.f}; }
    __device__ __forceinline__ void operator()(const f32x4 (&acc)[2][2][4][2], const pg8::Unit& u, int wr, int wc, int fr, int fq) const {
        float* base; int ld, c0;
        if (u.pn < 4) { base = kvp; ld = 1024; c0 = u.pn * 256; } else if (u.pn < 6) { base = winf; ld = 512; c0 = (u.pn - 4) * 256; }
        else if (u.pn < 14) { base = qraw; ld = 2048; c0 = (u.pn - 6) * 256; } else { base = gate; ld = 256; c0 = 0; }
        const int row0 = u.pm * 256 + wr * 64 + fr, col0 = c0 + wc * 32 + 4 * fq;
#pragma unroll
        for (int ai = 0; ai < 2; ++ai)
#pragma unroll
            for (int m = 0; m < 4; ++m) { const int row = row0 + ai * 128 + m * 16; const float rs = row_rs(ssq_in, row, fq); float* rowp = base + (size_t)row * ld + col0;
#pragma unroll
                for (int bj = 0; bj < 2; ++bj)
#pragma unroll
                    for (int n = 0; n < 2; ++n) { const f32x4 v = acc[ai][bj][m][n] * rs; *(GAS f32x4*)(rowp + bj * 128 + n * 16) = v;
                        if (u.pn < 2) {
                            const int b = row >> 12, t = row & 4095; u32x2 w; w.x = pk2(v[0], v[1]); w.y = pk2(v[2], v[3]);
                            *(GAS u32x2*)(acmp + ((size_t)(u.pn * 1024 + (b * 2 + bj) * 256 + (t >> 4))) * 2048 + (t & 15) * 128 + wc * 32 + n * 16 + 4 * fq) = w; } } }
    }
};
struct EpiPlain {
    static constexpr bool PERM = false;
    float* C;
    __device__ __forceinline__ void init(f32x4 (&acc)[2][2][4][2], const pg8::Unit&, int, int, int, int) const {
#pragma unroll
        for (int a = 0; a < 2; ++a)
#pragma unroll
            for (int b = 0; b < 2; ++b)
#pragma unroll
                for (int m = 0; m < 4; ++m)
#pragma unroll
                    for (int n = 0; n < 2; ++n) acc[a][b][m][n] = (f32x4){0.f, 0.f, 0.f, 0.f}; }
    __device__ __forceinline__ void operator()(const f32x4 (&acc)[2][2][4][2], const pg8::Unit& u, int wr, int wc, int fr, int fq) const {
        const int row0 = u.pm * 256 + wr * 64 + fr, col0 = wc * 32 + 4 * fq;
#pragma unroll
        for (int ai = 0; ai < 2; ++ai)
#pragma unroll
            for (int m = 0; m < 4; ++m) { float* rowp = C + (size_t)(row0 + ai * 128 + m * 16) * 256 + col0;
#pragma unroll
                for (int bj = 0; bj < 2; ++bj)
#pragma unroll
                    for (int n = 0; n < 2; ++n) *(GAS f32x4*)(rowp + bj * 128 + n * 16) = acc[ai][bj][m][n]; }
    }
};

struct SkEpi { int mode; const float* ssq_in; float* f0; float* f1; const float* base; bf16* b0; float* ssq_out; };
__device__ __forceinline__ void skinny_gemm(LAS unsigned char* lds, const bf16* A, int K, const bf16* Bt, int N, const SkEpi e, int first = 0) {
    const int tid = tid_opaque(), wave = tid >> 6, lane = tid & 63, G = (int)gridDim.x - first, bx = (int)blockIdx.x - first;
    if (bx < 0 || bx >= N / 32) return;
    LAS float* red = (LAS float*)lds;
    LAS float* rst = (LAS float*)(lds + 8 * 32 * 33 * 4);
    if (e.ssq_in) { const int row = tid >> 4, sub = tid & 15; const GAS f32x4* q = (const GAS f32x4*)(e.ssq_in + row * 64 + sub * 4); const f32x4 a = q[0];
        float s = (a.x + a.y) + (a.z + a.w); s += __shfl_xor(s, 1); s += __shfl_xor(s, 2); s += __shfl_xor(s, 4); s += __shfl_xor(s, 8);
        if (sub == 0) rst[row] = rsqrtf(s * (1.0f / 2048.0f) + EPS); }
    else if (tid < 32) rst[tid] = 1.0f;
    __syncthreads();
    const int r = lane & 31, h = lane >> 5, kw = K / 8;
    for (int u = bx; u < N / 32; u += G) {
        const int n0 = u * 32;
        const GAS bf16* ap = (const GAS bf16*)A + (size_t)r * K + wave * kw + h * 32;
        const GAS bf16* bp = (const GAS bf16*)Bt + (size_t)(n0 + r) * K + wave * kw + h * 32;
        f32x16 acc;
#pragma unroll
        for (int i = 0; i < 16; ++i) acc[i] = 0.f;
        for (int k = 0; k < kw; k += 256) {
            bf16x8 a[16], b[16];
#pragma unroll
            for (int j = 0; j < 16; ++j) { a[j] = *(const GAS bf16x8*)(ap + k + 64 * (j >> 2) + 8 * (j & 3)); b[j] = *(const GAS bf16x8*)(bp + k + 64 * (j >> 2) + 8 * (j & 3)); }
#pragma unroll
            for (int j = 0; j < 16; ++j) acc = __builtin_amdgcn_mfma_f32_32x32x16_bf16(a[j], b[j], acc, 0, 0, 0);
        }
#pragma unroll
        for (int q = 0; q < 16; ++q) red[wave * (32 * 33) + ((q & 3) + 8 * (q >> 2) + 4 * h) * 33 + r] = acc[q];
        __syncthreads();
        const int j = tid & 31, i0 = tid >> 5;
#pragma unroll
        for (int ii = 0; ii < 2; ++ii) { const int i = i0 + 16 * ii; float v = 0.f;
#pragma unroll
            for (int w = 0; w < 8; ++w) v += red[w * (32 * 33) + i * 33 + j];
            const int col = n0 + j; const float rs = rst[i]; float o = 0.f;
            if (e.mode == 0) { e.f0[(size_t)i * N + col] = v * rs; }
            else if (e.mode == 1) { const float z = gelu_t(v * rs); if (col < 2048) e.f0[i * 2048 + col] = z; else e.f1[i * 2048 + col - 2048] = z; }
            else if (e.mode == 2) { o = e.base[(size_t)i * N + col] + v; e.f0[(size_t)i * N + col] = o; if (e.b0) e.b0[(size_t)i * N + col] = (bf16)f2bf(o); }
            else { const float a = fmaxf(v * rs, 0.f); e.b0[(size_t)i * N + col] = (bf16)f2bf(a * a); }
            if (e.mode == 2 && e.ssq_out) { float q = o * o; q += __shfl_xor(q, 1); q += __shfl_xor(q, 2); q += __shfl_xor(q, 4); q += __shfl_xor(q, 8); q += __shfl_xor(q, 16);
                if (j == 0) e.ssq_out[i * 64 + u] = q; } }
        __syncthreads();
    }
}

__device__ __forceinline__ void norm_rope2(float& a, float& b, const float* gain, const float* rope_row, int lane, bool do_rope) {
    const float ss = wave_sum(a * a + b * b); const float r = rsqrtf(ss * (1.0f / 128.0f) + EPS);
    a = a * r * gain[2 * lane]; b = b * r * gain[2 * lane + 1];
    if (do_rope) {
        const float pa = __shfl_xor(a, 8), pb = __shfl_xor(b, 8);
        if (lane < 16) { const int i = 2 * (lane & 7); const float c0 = rope_row[i], c1 = rope_row[i + 1], s0 = rope_row[16 + i], s1 = rope_row[16 + i + 1];
            if (lane < 8) { a = a * c0 - pa * s0; b = b * c1 - pb * s1; } else { a = a * c0 + pa * s0; b = b * c1 + pb * s1; } }
    }
}

__device__ __forceinline__ void transpose_item(const float* W, const float* gain, int K, int Nv, int ldw, bf16* WT, int row_off, int nblk, LAS float* scr, int item, int lane) {
    const int kb = item / nblk, nb = item % nblk, k0 = 64 * kb, n0 = 64 * nb; const int nn = n0 + 4 * (lane & 15), kq = lane >> 4;
    f32x4 v[16];
#pragma unroll
    for (int jx = 0; jx < 16; ++jx) { v[jx] = (f32x4){0.f, 0.f, 0.f, 0.f}; if (nn < Nv) v[jx] = __builtin_nontemporal_load((const GAS f32x4*)(W + (size_t)(k0 + 4 * jx + kq) * ldw + nn)); }
#pragma unroll
    for (int jx = 0; jx < 16; ++jx) { const int kk = 4 * jx + kq; const float gg = gain ? gain[k0 + kk] : 1.0f; LAS float* d = scr + kk * 65 + 4 * (lane & 15);
        d[0] = v[jx].x * gg; d[1] = v[jx].y * gg; d[2] = v[jx].z * gg; d[3] = v[jx].w * gg; }
    LDS_WAIT(); asm volatile("" ::: "memory");
#pragma unroll
    for (int jj = 0; jj < 8; ++jj) { const int id = lane + 64 * jj, n = id >> 3, ck = id & 7; const LAS float* s = scr + (8 * ck) * 65 + n;
        u32x4 o; o.x = pk2(s[0 * 65], s[1 * 65]); o.y = pk2(s[2 * 65], s[3 * 65]); o.z = pk2(s[4 * 65], s[5 * 65]); o.w = pk2(s[6 * 65], s[7 * 65]);
        *(GAS u32x4*)(WT + (size_t)(row_off + n0 + n) * K + k0 + 8 * ck) = o; }
    LDS_WAIT(); asm volatile("" ::: "memory");
}
__device__ __forceinline__ void row_to_bf16_ssq(const float* xrow, bf16* orow, float* slots, int nslots, int lane) {
    const GAS f32x4* xr = (const GAS f32x4*)xrow + lane; f32x4 v[8]; float s = 0.f;
#pragma unroll
    for (int j = 0; j < 8; ++j) { v[j] = xr[64 * j]; s += (v[j].x * v[j].x + v[j].y * v[j].y) + (v[j].z * v[j].z + v[j].w * v[j].w); }
    s = wave_sum(s);
    GAS unsigned long long* o8 = (GAS unsigned long long*)orow + lane;
#pragma unroll
    for (int j = 0; j < 8; ++j) o8[64 * j] = (unsigned long long)pk2(v[j].x, v[j].y) | ((unsigned long long)pk2(v[j].z, v[j].w) << 32);
    if (lane < nslots) slots[lane] = lane == 0 ? s : 0.f;
}
__device__ __forceinline__ void late_weights(const Params& p, LAS unsigned char* lds, int part, int wg, int nwg) {
    const int tid = tid_opaque(), wave = tid >> 6, lane = tid & 63; LAS float* scr = (LAS float*)(lds + wave * 16640);
    const int n = part == 0 ? 1024 + 4096 : 4096;
    for (int it = wg * 8 + wave; it < n; it += nwg * 8) { int r = it;
#define TR(W_, g_, WT_, K_, Nv_, ldw_, roff_, nblk_) { const int cnt = ((K_) / 64) * (nblk_); if (r < cnt) { transpose_item(W_, g_, K_, Nv_, ldw_, WT_, roff_, nblk_, scr, r, lane); continue; } r -= cnt; }
        if (part == 0) { TR(p.b_w_out(), nullptr, p.W_bout(), 2048, 2048, 2048, 0, 32)
                         TR(p.mlp_w_up() + (size_t)2048 * 8192, p.mlp_norm() + 2048, p.W_up1(), 2048, 8192, 8192, 0, 128) }
        else { TR(p.mlp_w_down() + (size_t)8192 * 2048, nullptr, p.W_dn1(), 8192, 2048, 2048, 0, 32) }
#undef TR
    }
}
__device__ __forceinline__ void cmp_stream_gemm(const Params& p, LAS unsigned char* lds) {
    const int tid = tid_opaque(), wave = tid >> 6, lane = tid & 63, c4 = lane >> 4, i = lane & 15, G = gridDim.x;
    unsigned sg[8], sl[8];
#pragma unroll
    for (int k = 0; k < 8; ++k) { const int id = tid + NT * k, n = id >> 4, q = id & 15; sg[k] = (unsigned)(n * 2048 + q * 8); sl[k] = (unsigned)(n * 256 + ((q ^ (n & 15)) * 16)); }
    for (int bp = blockIdx.x; bp < 512; bp += G) {
        const int cc = (bp >> 1) & 1, g = bp & 1, rem = bp >> 2, b = rem >> 2, q8 = rem & 3;
        const int n0 = (q8 * 8 + wave) * 16, pos0 = 16 * (n0 + i); const int page = p.ptab()[b * NPAGE + (pos0 >> 7)];
        const float* arow = p.cache() + ((size_t)page * 128 + (pos0 & 127)) * 1024 + cc * 256 + g * 128 + 8 * c4;
        const bf16* wsrc = p.W_cmp() + (size_t)cc * 256 * 2048;
        f32x4 acc[16];
#pragma unroll
        for (int nt = 0; nt < 16; ++nt) acc[nt] = (f32x4){0.f, 0.f, 0.f, 0.f};
        f32x4 ac[8], an[8]; u32x4 wb[8];
#define CS_BAR() do { asm volatile("s_waitcnt lgkmcnt(0)" ::: "memory"); __builtin_amdgcn_s_barrier(); asm volatile("" ::: "memory"); } while (0)
#pragma unroll
        for (int ks = 0; ks < 4; ++ks) { ac[2 * ks] = __builtin_nontemporal_load((const GAS f32x4*)(arow + 32 * ks)); ac[2 * ks + 1] = __builtin_nontemporal_load((const GAS f32x4*)(arow + 32 * ks + 4)); }
#pragma unroll
        for (int k = 0; k < 8; ++k) wb[k] = *(const GAS u32x4*)(wsrc + sg[k]);
#pragma unroll
        for (int k = 0; k < 8; ++k) *(LAS u32x4*)(lds + sl[k]) = wb[k];
        CS_BAR();
        for (int r = 0; r < 16; ++r) { const int buf = (r & 1) * 65536;
            if (r + 1 < 16) {
#pragma unroll
                for (int k = 0; k < 8; ++k) wb[k] = *(const GAS u32x4*)(wsrc + (r + 1) * 128 + sg[k]);
#pragma unroll
                for (int ks = 0; ks < 4; ++ks) { an[2 * ks] = __builtin_nontemporal_load((const GAS f32x4*)(arow + (size_t)(r + 1) * 1024 + 32 * ks)); an[2 * ks + 1] = __builtin_nontemporal_load((const GAS f32x4*)(arow + (size_t)(r + 1) * 1024 + 32 * ks + 4)); } }
#pragma unroll
            for (int ks = 0; ks < 4; ++ks) { u32x4 w; w.x = pk2(ac[2 * ks].x, ac[2 * ks].y); w.y = pk2(ac[2 * ks].z, ac[2 * ks].w); w.z = pk2(ac[2 * ks + 1].x, ac[2 * ks + 1].y); w.w = pk2(ac[2 * ks + 1].z, ac[2 * ks + 1].w);
                const bf16x8 af = __builtin_bit_cast(bf16x8, w);
#pragma unroll
                for (int nt = 0; nt < 16; ++nt) acc[nt] = __builtin_amdgcn_mfma_f32_16x16x32_bf16(*(const LAS bf16x8*)(lds + buf + (16 * nt + i) * 256 + (((4 * ks + c4) ^ i) * 16)), af, acc[nt], 0, 0, 0);
                asm volatile("" ::: "memory"); }
            if (r + 1 < 16) {
#pragma unroll
                for (int k = 0; k < 8; ++k) *(LAS u32x4*)(lds + (65536 - buf) + sl[k]) = wb[k];
#pragma unroll
                for (int k = 0; k < 8; ++k) ac[k] = an[k]; }
            CS_BAR(); }
#undef CS_BAR
        float* frow = p.FCMPS() + ((size_t)cc * 32768 + (size_t)(b * 2 + g) * 512 + n0 + i) * 256 + 4 * c4;
#pragma unroll
        for (int nt = 0; nt < 16; ++nt) *(GAS f32x4*)(frow + 16 * nt) = acc[nt];
    }
}
__device__ __forceinline__ void phase0(const Params& p, LAS unsigned char* lds) {
    const int tid = tid_opaque(), wave = tid >> 6, lane = tid & 63; const int gw = blockIdx.x * 8 + wave, NGW = gridDim.x * 8;
    LAS float* scr = (LAS float*)(lds + wave * 16640);
    constexpr int NITEMS = 2048 + 1024 + 2 * 4096 + 768 + 1152 + 4 * 64;
    for (int it = gw; it < NITEMS; it += NGW) {
        int r = it;
#define TR(W_, g_, WT_, K_, Nv_, ldw_, roff_, nblk_) { const int cnt = ((K_) / 64) * (nblk_); if (r < cnt) { transpose_item(W_, g_, K_, Nv_, ldw_, WT_, roff_, nblk_, scr, r, lane); continue; } r -= cnt; }
        TR(p.a_w_in(), p.a_norm(), p.W_ain(), 2048, 4096, 4096, 0, 64)
        TR(p.a_w_out(), nullptr, p.W_aout(), 2048, 2048, 2048, 0, 32)
        TR(p.mlp_w_up(), p.mlp_norm(), p.W_up0(), 2048, 8192, 8192, 0, 128)
        TR(p.mlp_w_down(), nullptr, p.W_dn0(), 8192, 2048, 2048, 0, 32)
        TR(p.w_kv(), p.kv_norm(), p.W_kvq(), 2048, 1536, 1536, 0, 24)
        TR(p.b_w_in(), p.b_norm(), p.W_kvq(), 2048, 2096, 2096, 1536, 36)
        TR(p.cmp_w1(), nullptr, p.W_cmp(), 2048, 128, 128, 0, 2)
        TR(p.cmp_w1() + (size_t)16 * 128 * 128, nullptr, p.W_cmp(), 2048, 128, 128, 128, 2)
        TR(p.cmp_w1() + (size_t)32 * 128 * 128, nullptr, p.W_cmp(), 2048, 128, 128, 256, 2)
        TR(p.cmp_w1() + (size_t)48 * 128 * 128, nullptr, p.W_cmp(), 2048, 128, 128, 384, 2)
#undef TR
    }
    for (int m = gw; m < MP; m += NGW) row_to_bf16_ssq(p.x_p() + (size_t)m * D, p.XB() + (size_t)m * D, p.x_ssq() + (size_t)m * 32, 32, lane);
    for (int m = gw; m < MS; m += NGW) row_to_bf16_ssq(p.x_s() + (size_t)m * D, p.XSB() + (size_t)m * D, p.xs_ssq() + (size_t)m * 64, 64, lane);
    for (int pos = gw; pos < 8208; pos += NGW) if (lane < 16) {
        const float inv = (float)pow(500000.0, -(double)(2 * lane) / 32.0); const float ang = (float)pos * inv;
        p.ROPE()[pos * 32 + lane] = (float)cos((double)ang); p.ROPE()[pos * 32 + 16 + lane] = (float)sin((double)ang); }
    for (int it = gw; it < 64; it += NGW) { const float* pe = p.cmp_pe() + (size_t)it * 128; const float* w = p.cmp_w1() + (size_t)it * 128 * 128; float a0 = 0.f, a1 = 0.f;
        for (int d = 0; d < 128; ++d) { const float x = pe[d]; a0 += x * w[d * 128 + lane]; a1 += x * w[d * 128 + 64 + lane]; }
        p.CBIAS()[it * 128 + lane] = a0; p.CBIAS()[it * 128 + 64 + lane] = a1; }
    for (int it = gw; it < MS * 128; it += NGW) { const int b = it >> 7, i0 = (it & 127) * 4; f32x4 v[8];
#pragma unroll
        for (int q = 0; q < 4; ++q) { const int i = i0 + q < 511 ? i0 + q : 510; const GAS f32x4* src = (const GAS f32x4*)(p.state() + ((size_t)b * 512 + i + 1) * 512) + lane; v[2 * q] = src[0]; v[2 * q + 1] = src[64]; }
#pragma unroll
        for (int q = 0; q < 4; ++q) if (i0 + q < 511) { GAS f32x4* dst = (GAS f32x4*)(p.out + O_WINS + ((size_t)b * 512 + i0 + q) * 512) + lane; dst[0] = v[2 * q]; dst[64] = v[2 * q + 1]; } }
}

__device__ __forceinline__ void gating_block(const Params& p, LAS unsigned char* lds) {
    const int tid = tid_opaque(), wave = tid >> 6, lane = tid & 63, c = lane >> 4, j = lane & 15, G = gridDim.x;
    LAS float* rvs = (LAS float*)(lds + 34816);
    const int tt = 16 * wave + j, nkk = (wave >> 1) + 1;
    int gcur = -1; bf16x8 wf[4]; float bias = 0.f; f32x2 gn = {0.f, 0.f};
    float rsv = 0.f; unsigned vw0[8], vw1[8]; u32x2 uu[8];
#define GT_LOAD(bi_) do { const int g_ = (bi_) & 15, m0_ = ((bi_) >> 4) * 128; \
        if (tid < 128) { const GAS f32x4* pp_ = (const GAS f32x4*)(p.v_ssq() + (size_t)(m0_ + tid) * 32); float s_ = 0.f; \
            _Pragma("unroll") for (int k = 0; k < 8; ++k) { const f32x4 x_ = pp_[k]; s_ += (x_.x + x_.y) + (x_.z + x_.w); } rsv = s_; } \
        _Pragma("unroll") for (int k = 0; k < 8; ++k) { const int idx_ = tid + NT * k, s2_ = (idx_ >> 6) * 2, d2_ = (idx_ & 63) * 2; \
            vw0[k] = *(const GAS unsigned*)(p.V() + (size_t)(m0_ + s2_) * 2048 + g_ * 128 + d2_); vw1[k] = *(const GAS unsigned*)(p.V() + (size_t)(m0_ + s2_ + 1) * 2048 + g_ * 128 + d2_); } \
        _Pragma("unroll") for (int dt = 0; dt < 8; ++dt) uu[dt] = *(const GAS u32x2*)(p.U() + (size_t)(m0_ + tt) * 2048 + g_ * 128 + 4 * c + 16 * dt); } while (0)
    int bi = blockIdx.x;
    if (bi < 1024) GT_LOAD(bi);
    for (; bi < 1024; bi += G) { const int g = bi & 15, m0 = (bi >> 4) * 128;
        if (g != gcur) { gcur = g;
#pragma unroll
            for (int kk = 0; kk < 4; ++kk) { f32x4 x0 = {0.f, 0.f, 0.f, 0.f}, x1 = {0.f, 0.f, 0.f, 0.f}; const int s0 = 32 * kk + 8 * c;
                if (kk < nkk) { const GAS f32x4* wp = (const GAS f32x4*)(p.a_w_s() + (size_t)(g * 128 + tt) * 128 + s0); x0 = wp[0]; x1 = wp[1]; }
                x0.x = s0 + 0 <= tt ? x0.x : 0.f; x0.y = s0 + 1 <= tt ? x0.y : 0.f; x0.z = s0 + 2 <= tt ? x0.z : 0.f; x0.w = s0 + 3 <= tt ? x0.w : 0.f;
                x1.x = s0 + 4 <= tt ? x1.x : 0.f; x1.y = s0 + 5 <= tt ? x1.y : 0.f; x1.z = s0 + 6 <= tt ? x1.z : 0.f; x1.w = s0 + 7 <= tt ? x1.w : 0.f;
                u32x4 w; w.x = pk2(x0.x, x0.y); w.y = pk2(x0.z, x0.w); w.z = pk2(x1.x, x1.y); w.w = pk2(x1.z, x1.w); wf[kk] = __builtin_bit_cast(bf16x8, w); }
            bias = p.a_b_s()[g * 128 + tt]; gn = *(const GAS f32x2*)(p.a_v_norm() + g * 128 + (tid & 63) * 2); }
        if (tid < 128) rvs[tid] = rsqrtf(rsv * (1.0f / 2048.0f) + EPS);
        __syncthreads();
#pragma unroll
        for (int k = 0; k < 8; ++k) { const int idx = tid + NT * k, s2 = (idx >> 6) * 2, d2 = (idx & 63) * 2; const unsigned w0 = vw0[k], w1 = vw1[k];
            const float r0 = rvs[s2], r1 = rvs[s2 + 1];
            *(LAS unsigned*)(lds + d2 * 272 + s2 * 2) = pk2(bf2f(w0 & 0xffffu) * r0 * gn.x, bf2f(w1 & 0xffffu) * r1 * gn.x);
            *(LAS unsigned*)(lds + (d2 + 1) * 272 + s2 * 2) = pk2(bf2f(w0 >> 16) * r0 * gn.y, bf2f(w1 >> 16) * r1 * gn.y); }
        u32x2 uc[8];
#pragma unroll
        for (int dt = 0; dt < 8; ++dt) uc[dt] = uu[dt];
        __syncthreads();
        if (bi + G < 1024) GT_LOAD(bi + G);
        f32x4 acc[8];
#pragma unroll
        for (int dt = 0; dt < 8; ++dt) acc[dt] = (f32x4){0.f, 0.f, 0.f, 0.f};
#pragma unroll
        for (int kk = 0; kk < 4; ++kk) if (kk < nkk) {
#pragma unroll
            for (int dt = 0; dt < 8; ++dt) acc[dt] = __builtin_amdgcn_mfma_f32_16x16x32_bf16(*(const LAS bf16x8*)(lds + (16 * dt + j) * 272 + (4 * kk + c) * 16), wf[kk], acc[dt], 0, 0, 0); }
        const size_t o0 = (size_t)(m0 + tt) * 2048 + g * 128 + 4 * c;
#pragma unroll
        for (int dt = 0; dt < 8; ++dt) { const u32x2 ux = uc[dt]; u32x2 w;
            w.x = pk2(bf2f(ux.x & 0xffffu) * (acc[dt][0] + bias), bf2f(ux.x >> 16) * (acc[dt][1] + bias)); w.y = pk2(bf2f(ux.y & 0xffffu) * (acc[dt][2] + bias), bf2f(ux.y >> 16) * (acc[dt][3] + bias));
            *(GAS u32x2*)(p.GT() + o0 + 16 * dt) = w; }
        __syncthreads();
    }
#undef GT_LOAD
}
__device__ __forceinline__ void sample_gating_row(const Params& p, int i, int lane) {
    const GAS f32x4* vr = (const GAS f32x4*)(p.VS() + (size_t)i * 2048) + lane; f32x4 v[8]; float s = 0.f;
#pragma unroll
    for (int j = 0; j < 8; ++j) { v[j] = vr[64 * j]; s += (v[j].x * v[j].x + v[j].y * v[j].y) + (v[j].z * v[j].z + v[j].w * v[j].w); }
    const float rv = rsqrtf(wave_sum(s) * (1.0f / 2048.0f) + EPS);
#pragma unroll
    for (int j = 0; j < 8; ++j) { const int col = 4 * (lane + 64 * j), g = col >> 7; const float w00 = p.a_w_s()[(size_t)g * 128 * 128], b0 = p.a_b_s()[g * 128];
        const f32x4 gn = *(const GAS f32x4*)(p.a_v_norm() + col); const f32x4 vn = v[j] * rv * gn; *(GAS f32x4*)(p.out + O_VAS + (size_t)i * 2048 + col) = vn;
        const f32x4 uu = *(const GAS f32x4*)(p.US() + (size_t)i * 2048 + col); const f32x4 o = uu * (vn * w00 + b0);
        u32x2 w; w.x = pk2(o.x, o.y); w.y = pk2(o.z, o.w); *(GAS u32x2*)(p.GTS() + (size_t)i * 2048 + col) = w; }
}

constexpr int CW_IMG = 34816, CW_BIAS = 4 * CW_IMG + 64;
__device__ __forceinline__ void cmp_w2_to_lds(const Params& p, LAS unsigned char* lds) {
    const int tid = tid_opaque();
    for (int k0 = 0; k0 < 32; k0 += 8) { float w0[8], w1[8];
#pragma unroll
        for (int k = 0; k < 8; ++k) { const int idx = tid + NT * (k0 + k), cm = idx >> 13, rem = idx & 8191, e2 = rem & 127, e = (rem >> 7) * 2;
            w0[k] = p.cmp_w2()[(size_t)cm * 16384 + e * 128 + e2]; w1[k] = p.cmp_w2()[(size_t)cm * 16384 + (e + 1) * 128 + e2]; }
#pragma unroll
        for (int k = 0; k < 8; ++k) { const int idx = tid + NT * (k0 + k), cm = idx >> 13, rem = idx & 8191, e2 = rem & 127, e = (rem >> 7) * 2;
            const unsigned h0 = f2bf(w0[k]), h1 = f2bf(w1[k]); const unsigned l0 = f2bf(w0[k] - bf2f(h0)), l1 = f2bf(w1[k] - bf2f(h1));
            *(LAS unsigned*)(lds + (2 * cm) * CW_IMG + e2 * 272 + e * 2) = h0 | (h1 << 16); *(LAS unsigned*)(lds + (2 * cm + 1) * CW_IMG + e2 * 272 + e * 2) = l0 | (l1 << 16); } }
    if (tid < 256) ((LAS float*)(lds + CW_BIAS))[tid] = p.CBIASF()[tid];
}
template <int NS> __device__ __forceinline__ void cmp_finish16(const float* Fk, const float* Fv, size_t sstride, int i0, int nvalid, const LAS unsigned char* lds, const float* knorm0, const float* rope, int lane, f32x4 (&kc)[8], f32x4 (&vc)[8]) {
    const int c = lane >> 4, j = lane & 15; const int row = i0 + j < nvalid ? i0 + j : nvalid - 1;
    const LAS float* bias = (const LAS float*)(lds + CW_BIAS);
    bf16x8 hkh[4], hkl[4], hvh[4], hvl[4];
#pragma unroll
    for (int kk = 0; kk < 4; ++kk) { const int e0 = 32 * kk + 8 * c; float xk[8], xv[8];
#pragma unroll
        for (int q = 0; q < 8; ++q) { xk[q] = bias[e0 + q]; xv[q] = bias[128 + e0 + q]; }
#pragma unroll 1
        for (int ks = 0; ks < NS; ++ks) { const float* fk = Fk + ks * sstride + (size_t)(row - i0) * 256 + e0; const float* fv = Fv + ks * sstride + (size_t)(row - i0) * 256 + e0;
            const f32x4 a0 = *(const GAS f32x4*)fk, a1 = *(const GAS f32x4*)(fk + 4), b0 = *(const GAS f32x4*)(fk + 256 + 128), b1 = *(const GAS f32x4*)(fk + 256 + 128 + 4);
            const f32x4 c0 = *(const GAS f32x4*)fv, c1 = *(const GAS f32x4*)(fv + 4), d0 = *(const GAS f32x4*)(fv + 256 + 128), d1 = *(const GAS f32x4*)(fv + 256 + 128 + 4);
            xk[0] += a0.x + b0.x; xk[1] += a0.y + b0.y; xk[2] += a0.z + b0.z; xk[3] += a0.w + b0.w; xk[4] += a1.x + b1.x; xk[5] += a1.y + b1.y; xk[6] += a1.z + b1.z; xk[7] += a1.w + b1.w;
            xv[0] += c0.x + d0.x; xv[1] += c0.y + d0.y; xv[2] += c0.z + d0.z; xv[3] += c0.w + d0.w; xv[4] += c1.x + d1.x; xv[5] += c1.y + d1.y; xv[6] += c1.z + d1.z; xv[7] += c1.w + d1.w; }
        unsigned kh[8], kl[8], vh[8], vl[8];
#pragma unroll
        for (int q = 0; q < 8; ++q) { const float hk = silu_f(xk[q]), hv = silu_f(xv[q]); kh[q] = f2bf(hk); kl[q] = f2bf(hk - bf2f(kh[q])); vh[q] = f2bf(hv); vl[q] = f2bf(hv - bf2f(vh[q])); }
        u32x4 w;
        w.x = kh[0] | (kh[1] << 16); w.y = kh[2] | (kh[3] << 16); w.z = kh[4] | (kh[5] << 16); w.w = kh[6] | (kh[7] << 16); hkh[kk] = __builtin_bit_cast(bf16x8, w);
        w.x = kl[0] | (kl[1] << 16); w.y = kl[2] | (kl[3] << 16); w.z = kl[4] | (kl[5] << 16); w.w = kl[6] | (kl[7] << 16); hkl[kk] = __builtin_bit_cast(bf16x8, w);
        w.x = vh[0] | (vh[1] << 16); w.y = vh[2] | (vh[3] << 16); w.z = vh[4] | (vh[5] << 16); w.w = vh[6] | (vh[7] << 16); hvh[kk] = __builtin_bit_cast(bf16x8, w);
        w.x = vl[0] | (vl[1] << 16); w.y = vl[2] | (vl[3] << 16); w.z = vl[4] | (vl[5] << 16); w.w = vl[6] | (vl[7] << 16); hvl[kk] = __builtin_bit_cast(bf16x8, w); if (NS > 1) asm volatile("" ::: "memory"); }
#pragma unroll
    for (int dt = 0; dt < 8; ++dt) { kc[dt] = (f32x4){0.f, 0.f, 0.f, 0.f}; vc[dt] = (f32x4){0.f, 0.f, 0.f, 0.f}; }
#pragma unroll
    for (int kk = 0; kk < 4; ++kk)
#pragma unroll
        for (int dt = 0; dt < 8; ++dt) { const LAS unsigned char* wp = lds + (16 * dt + j) * 272 + (4 * kk + c) * 16;
            const bf16x8 wkh = *(const LAS bf16x8*)wp, wkl = *(const LAS bf16x8*)(wp + CW_IMG), wvh = *(const LAS bf16x8*)(wp + 2 * CW_IMG), wvl = *(const LAS bf16x8*)(wp + 3 * CW_IMG);
            kc[dt] = __builtin_amdgcn_mfma_f32_16x16x32_bf16(wkl, hkh[kk], kc[dt], 0, 0, 0); kc[dt] = __builtin_amdgcn_mfma_f32_16x16x32_bf16(wkh, hkl[kk], kc[dt], 0, 0, 0); kc[dt] = __builtin_amdgcn_mfma_f32_16x16x32_bf16(wkh, hkh[kk], kc[dt], 0, 0, 0);
            vc[dt] = __builtin_amdgcn_mfma_f32_16x16x32_bf16(wvl, hvh[kk], vc[dt], 0, 0, 0); vc[dt] = __builtin_amdgcn_mfma_f32_16x16x32_bf16(wvh, hvl[kk], vc[dt], 0, 0, 0); vc[dt] = __builtin_amdgcn_mfma_f32_16x16x32_bf16(wvh, hvh[kk], vc[dt], 0, 0, 0);
            if (dt & 1) asm volatile("" ::: "memory"); }
    float ss = 0.f;
#pragma unroll
    for (int dt = 0; dt < 8; ++dt) ss += (kc[dt][0] * kc[dt][0] + kc[dt][1] * kc[dt][1]) + (kc[dt][2] * kc[dt][2] + kc[dt][3] * kc[dt][3]);
    ss += __shfl_xor(ss, 16); ss += __shfl_xor(ss, 32); const float rn = rsqrtf(ss * (1.0f / 128.0f) + EPS);
#pragma unroll
    for (int dt = 0; dt < 8; ++dt) { const f32x4 gn = *(const GAS f32x4*)(knorm0 + 16 * dt + 4 * c); kc[dt] = kc[dt] * rn * gn; }
    const float* rr = rope + (size_t)(16 * (i0 + j) + 31) * 32; const f32x4 cs = *(const GAS f32x4*)(rr + 4 * c), sn = *(const GAS f32x4*)(rr + 16 + 4 * c);
    const f32x4 x1 = kc[0], x2 = kc[1]; kc[0] = x1 * cs - x2 * sn; kc[1] = x2 * cs + x1 * sn;
}

constexpr float QSC = 0.08838834764831845f * 1.4426950408889634f;
struct FinRow { f32x2 ks[2], wv[4], qv[16]; };
__device__ __forceinline__ void finish_row_load(const Params& p, int m, int lane, FinRow& r) {
    const float* kvp = p.out + O_KVP + (size_t)m * 1024; const float* wf = p.WINF() + (size_t)m * 512;
#pragma unroll
    for (int x = 0; x < 2; ++x) r.ks[x] = *(const GAS f32x2*)(kvp + (4 + x) * 128 + 2 * lane);
#pragma unroll
    for (int x = 0; x < 4; ++x) r.wv[x] = *(const GAS f32x2*)(wf + x * 128 + 2 * lane);
#pragma unroll
    for (int h = 0; h < 16; ++h) r.qv[h] = *(const GAS f32x2*)(p.QRAW() + (size_t)m * 2048 + h * 128 + 2 * lane);
}
__device__ __forceinline__ void finish_row_prompt(const Params& p, int m, int lane, const FinRow& r) {
    const int b = m >> 12, t = m & 4095; const float* rr = p.ROPE() + (size_t)t * 32;
    float* kvp = p.out + O_KVP + (size_t)m * 1024; float* wf = p.WINF() + (size_t)m * 512;
#pragma unroll
    for (int g = 0; g < 2; ++g) {
        { float a = r.ks[g].x, c = r.ks[g].y; norm_rope2(a, c, p.k_norm() + 128, rr, lane, true);
          *(GAS f32x2*)(kvp + 512 + g * 128 + 2 * lane) = (f32x2){a, c};
          *(GAS unsigned*)(p.KSLC() + ((size_t)(b * 2 + g) * 4096 + t) * 128 + 2 * lane) = pk2(a, c); }
        { float a = r.wv[g].x, c = r.wv[g].y; norm_rope2(a, c, p.k_norm() + 256, rr, lane, true);
          *(GAS f32x2*)(wf + g * 128 + 2 * lane) = (f32x2){a, c};
          *(GAS unsigned*)(p.KWIN() + ((size_t)(b * 2 + g) * 4096 + t) * 128 + 2 * lane) = pk2(a, c);
          if (t >= 3584) { float* wo = p.out + O_WINP + ((size_t)b * 512 + (t - 3584)) * 512; *(GAS f32x2*)(wo + g * 128 + 2 * lane) = (f32x2){a, c}; *(GAS f32x2*)(wo + 256 + g * 128 + 2 * lane) = r.wv[2 + g]; } }
    }
#pragma unroll
    for (int h = 0; h < 16; ++h) { float a = r.qv[h].x, c = r.qv[h].y; norm_rope2(a, c, p.b_q_norm(), rr, lane, true); *(GAS unsigned*)(p.QN() + (size_t)m * 2048 + h * 128 + 2 * lane) = pk2(a * QSC, c * QSC); }
}
__device__ __forceinline__ void vt_item(const Params& p, int item, LAS unsigned char* lds) {
    const int tile = item & 63, g = (item >> 6) & 1, b = (item >> 7) & 1, which = item >> 8, tid = tid_opaque();
    LAS float* tl = (LAS float*)lds;
    const int m0 = b * 4096 + tile * 64;
    const float* src = which == 0 ? p.out + O_KVP + (size_t)m0 * 1024 + 768 + g * 128 : p.WINF() + (size_t)m0 * 512 + 256 + g * 128; const int ld = which == 0 ? 1024 : 512;
    f32x4 v[4];
#pragma unroll
    for (int k = 0; k < 4; ++k) { const int idx = tid + NT * k, tt = idx >> 5, d4 = (idx & 31) * 4; v[k] = *(const GAS f32x4*)(src + (size_t)tt * ld + d4); }
#pragma unroll
    for (int k = 0; k < 4; ++k) { const int idx = tid + NT * k, tt = idx >> 5, d4 = (idx & 31) * 4; LAS float* d = tl + tt * 129 + d4; d[0] = v[k].x; d[1] = v[k].y; d[2] = v[k].z; d[3] = v[k].w; }
    __syncthreads();
    bf16* dst = (which == 0 ? p.VSLCT() : p.VWINT()) + (size_t)((b * 2 + g) * 64 + tile) * 8192;
#pragma unroll
    for (int k = 0; k < 2; ++k) { const int idx = tid + NT * k, d = idx >> 3, ck = idx & 7; const LAS float* s = tl + (8 * ck) * 129 + d;
        u32x4 o; o.x = pk2(s[0], s[129]); o.y = pk2(s[2 * 129], s[3 * 129]); o.z = pk2(s[4 * 129], s[5 * 129]); o.w = pk2(s[6 * 129], s[7 * 129]);
        *(GAS u32x4*)(dst + d * 64 + 8 * ck) = o; }
    __syncthreads();
}
__device__ __forceinline__ void finish_row_sample(const Params& p, int i, int lane) {
    const float* src = p.KVQS() + (size_t)i * NKVQ; const float* rr = p.ROPE() + (size_t)8192 * 32;
    float* kvs = p.out + O_KVS + (size_t)i * 1024; float* wrow = p.out + O_WINS + ((size_t)i * 512 + 511) * 512;
    for (int ch = 0; ch < 28; ++ch) { f32x2 v = *(const GAS f32x2*)(src + ch * 128 + 2 * lane); float a = v.x, c = v.y;
        if (ch < 12) { const int s = ch >> 1, g = ch & 1;
            if (s == 2) norm_rope2(a, c, p.k_norm() + 128, rr, lane, true);
            if (s == 4) norm_rope2(a, c, p.k_norm() + 256, rr, lane, true);
            if (s < 4) *(GAS f32x2*)(kvs + s * 256 + g * 128 + 2 * lane) = (f32x2){a, c}; else *(GAS f32x2*)(wrow + (s - 4) * 256 + g * 128 + 2 * lane) = (f32x2){a, c}; }
        else { const int h = ch - 12; norm_rope2(a, c, p.b_q_norm(), rr, lane, true); *(GAS f32x2*)(p.QS() + (size_t)i * 2048 + h * 128 + 2 * lane) = (f32x2){a, c}; } }
    if (lane < 48) p.GS()[i * 48 + lane] = sigmoid_f(src[3584 + lane]);
}

#define MFMA16(a, b, c) __builtin_amdgcn_mfma_f32_16x16x32_bf16(a, b, c, 0, 0, 0)
__device__ __forceinline__ bf16x8 pack_p(const f32x4 a, const f32x4 b) { u32x4 w; w.x = pk2(a[0], a[1]); w.y = pk2(a[2], a[3]); w.z = pk2(b[0], b[1]); w.w = pk2(b[2], b[3]); return __builtin_bit_cast(bf16x8, w); }
constexpr int AT_KB = 0, AT_VB = 32768, AT_PS = 65536, AT_UM = 65536 + 16384;
#define AT_ISSUE(kt, vt, doV) do { stK0 = *(const GAS u32x4*)((kt) + gK); stK1 = *(const GAS u32x4*)((kt) + gK + 32 * 128); \
    if (doV) { stV0 = *(const GAS u32x4*)((vt) + gV); stV1 = *(const GAS u32x4*)((vt) + gV + 4096); } } while (0)
#define AT_COMMIT(buf, doV) do { *(LAS u32x4*)(lds + AT_KB + (buf) * 16384 + lK) = stK0; *(LAS u32x4*)(lds + AT_KB + (buf) * 16384 + lK + 8192) = stK1; \
    if (doV) { *(LAS u32x4*)(lds + AT_VB + (buf) * 16384 + lV) = stV0; *(LAS u32x4*)(lds + AT_VB + (buf) * 16384 + lV + 8192) = stV1; } } while (0)
constexpr float AT_SHIFT = 16.0f;
#define AT_SCORES(buf, blk0, FULL, rowok, tlo, thi) \
    f32x4 s4[2][2]; \
    _Pragma("unroll") for (int pp = 0; pp < 2; ++pp) { f32x4 a0_ = {0.f, 0.f, 0.f, 0.f}, a1_ = {0.f, 0.f, 0.f, 0.f};                   \
        _Pragma("unroll") for (int kk = 0; kk < 4; ++kk) { a0_ = MFMA16(*(const LAS bf16x8*)(lds + AT_KB + (buf) * 16384 + (2 * pp) * 4096 + kofs[kk]), qf[kk], a0_); \
            a1_ = MFMA16(*(const LAS bf16x8*)(lds + AT_KB + (buf) * 16384 + (2 * pp + 1) * 4096 + kofs[kk]), qf[kk], a1_); } \
        s4[pp][0] = a0_; s4[pp][1] = a1_; \
        if (pp == 0) asm volatile("" ::: "memory"); } \
    _Pragma("unroll") for (int pp = 0; pp < 2; ++pp) _Pragma("unroll") for (int hb = 0; hb < 2; ++hb) _Pragma("unroll") for (int e = 0; e < 4; ++e) { \
        if ((FULL) == 0) { const int kpos_ = (blk0) + 32 * pp + 8 * c + 4 * hb + e; const bool ok_ = (rowok) && kpos_ <= (thi) && kpos_ >= (tlo); s4[pp][hb][e] = ok_ ? s4[pp][hb][e] : -1e30f; } \
        if ((FULL) == 1) s4[pp][hb][e] = (rowok) ? s4[pp][hb][e] : -1e30f; }
#define AT_PV(buf) \
    _Pragma("unroll") for (int pp = 0; pp < 2; ++pp) { const bf16x8 pf_ = pack_p(s4[pp][0], s4[pp][1]); \
        _Pragma("unroll") for (int dt = 0; dt < 8; ++dt) oa[dt] = MFMA16(*(const LAS bf16x8*)(lds + AT_VB + (buf) * 16384 + dt * 2048 + vofs[pp]), pf_, oa[dt]); \
        if (pp == 0) asm volatile("" ::: "memory"); }
#define AT_STEP_ONLINE(buf, blk0, FULL, rowok, tlo, thi) do { AT_SCORES(buf, blk0, FULL, rowok, tlo, thi) \
    float ps_ = 0.f; \
    _Pragma("unroll") for (int pp = 0; pp < 2; ++pp) _Pragma("unroll") for (int hb = 0; hb < 2; ++hb) _Pragma("unroll") for (int e = 0; e < 4; ++e) { \
        const float pv_ = __builtin_amdgcn_exp2f(s4[pp][hb][e] - AT_SHIFT); s4[pp][hb][e] = pv_; ps_ += pv_; } \
    l_run += ps_; \
    AT_PV(buf) } while (0)
#define AT_STEP_STATS(buf, blk0, thi) do { AT_SCORES(buf, blk0, 0, true, 0, thi) \
    float ps_ = 0.f; \
    _Pragma("unroll") for (int pp = 0; pp < 2; ++pp) _Pragma("unroll") for (int hb = 0; hb < 2; ++hb) _Pragma("unroll") for (int e = 0; e < 4; ++e) ps_ += __builtin_amdgcn_exp2f(s4[pp][hb][e] - AT_SHIFT); \
    l_run += ps_; } while (0)
#define AT_STEP_FINAL(buf, blk0, thi) do { AT_SCORES(buf, blk0, 0, true, 0, thi) \
    _Pragma("unroll") for (int pp = 0; pp < 2; ++pp) _Pragma("unroll") for (int hb = 0; hb < 2; ++hb) { _Pragma("unroll") for (int e = 0; e < 4; ++e) { \
        s4[pp][hb][e] = __builtin_amdgcn_exp2f(s4[pp][hb][e] - AT_SHIFT) * il_c; } \
        f32x4 hs_ = s4[pp][hb]; \
        _Pragma("unroll") for (int e = 0; e < 4; ++e) { float x_ = hs_[e]; x_ += __shfl_xor(x_, 1); x_ += __shfl_xor(x_, 2); x_ += __shfl_xor(x_, 4); hs_[e] = x_; } \
        if (r == 0) *(LAS f32x4*)(ps + qi * 256 + (blk0) + 32 * pp + 8 * c + 4 * hb) = hs_; } \
    AT_PV(buf) } while (0)

__device__ __forceinline__ void attn_prompt_unit(const Params& p, int b, int g, int t0w, LAS unsigned char* lds, int tid) {
    const int wave = tid >> 6, lane = tid & 63;
    const int c = lane >> 4, j = lane & 15, qi = j >> 3, r = j & 7, h = g * 8 + r;
    const int t0 = t0w + 2 * wave, t = t0 + qi, m = b * 4096 + t, bg = b * 2 + g;
    LAS float* ps = (LAS float*)(lds + AT_PS + wave * 2048);
    unsigned kofs[4], vofs[2];
#pragma unroll
    for (int kk = 0; kk < 4; ++kk) kofs[kk] = (unsigned)(j * 256 + (((4 * kk + c) ^ j) * 16));
#pragma unroll
    for (int pp = 0; pp < 2; ++pp) vofs[pp] = (unsigned)(j * 128 + (((4 * pp + c) ^ ((j >> 1) & 7)) * 16));
    unsigned gK, lK, gV, lV;
    { const int rho = tid >> 4, q = tid & 15, i = rho & 15, t4 = rho >> 4; const int key = 32 * (t4 >> 1) + 4 * (t4 & 1) + 8 * (i >> 2) + (i & 3);
      gK = (unsigned)(key * 128 + q * 8); lK = (unsigned)(rho * 256 + ((q ^ i) * 16));
      const int d = tid >> 3, qv = tid & 7; gV = (unsigned)(d * 64 + qv * 8); lV = (unsigned)(d * 128 + ((qv ^ ((d >> 1) & 7)) * 16)); }
    u32x4 stK0, stK1, stV0, stV1;
    bf16x8 qf[4];
    { const GAS bf16* qp = (const GAS bf16*)p.QN() + (size_t)m * 2048 + h * 128 + 8 * c;
#pragma unroll
      for (int kk = 0; kk < 4; ++kk) qf[kk] = *(const GAS bf16x8*)(qp + 32 * kk); }
    f32x4 res[8]; f32x4 oa[8]; float l_run;
    int cb = 0;
    const GAS bf16* kbW = (const GAS bf16*)p.KWIN() + (size_t)(bg * 4096) * 128;
    const GAS bf16* vtbW = (const GAS bf16*)p.VWINT() + (size_t)(bg * 64) * 8192;
    const int w_lo = (t0w >= 511 ? t0w - 511 : 0) >> 6, w_hi = (t0w + 15) >> 6, w_nb = w_hi - w_lo + 1;
    {
        const GAS bf16* kc = (const GAS bf16*)p.KC() + (size_t)(bg * 256) * 128;
        const GAS bf16* vct = (const GAS bf16*)p.VCT() + (size_t)(bg * 4) * 8192;
        const int nvis = (t >= 31) ? ((t - 31) >> 4) + 1 : 0;
        const int tl = t0w + 15; const int nvis_wg = (tl >= 31) ? ((tl - 31) >> 4) + 1 : 0; const int nb = (nvis_wg + 63) >> 6;
        l_run = 0.f;
        if (nb > 0) { AT_ISSUE(kc, vct, false); AT_COMMIT(0, false); } else { AT_ISSUE(kbW + (size_t)w_lo * 8192, vtbW + (size_t)w_lo * 8192, true); AT_COMMIT(0, true); }
        __syncthreads();
        for (int n = 0; n < nb; ++n) {
            if (n + 1 < nb) AT_ISSUE(kc + (size_t)(n + 1) * 8192, vct, false); else AT_ISSUE(kc, vct, true);
            AT_STEP_STATS(cb, 64 * n, nvis - 1);
            if (n + 1 < nb) AT_COMMIT(cb ^ 1, false); else AT_COMMIT(cb ^ 1, true);
            __syncthreads(); cb ^= 1; }
        float lt = l_run; lt += __shfl_xor(lt, 16); lt += __shfl_xor(lt, 32); const float il_c = lt > 0.f ? 1.0f / lt : 0.f;
#pragma unroll
        for (int dt = 0; dt < 8; ++dt) oa[dt] = (f32x4){0.f, 0.f, 0.f, 0.f};
        if (lane < 64) { *(LAS f32x4*)(ps + 4 * lane) = (f32x4){0.f, 0.f, 0.f, 0.f}; *(LAS f32x4*)(ps + 256 + 4 * lane) = (f32x4){0.f, 0.f, 0.f, 0.f}; }
        for (int n = 0; n < nb; ++n) {
            if (n + 1 < nb) AT_ISSUE(kc + (size_t)(n + 1) * 8192, vct + (size_t)(n + 1) * 8192, true); else AT_ISSUE(kbW + (size_t)w_lo * 8192, vtbW + (size_t)w_lo * 8192, true);
            AT_STEP_FINAL(cb, 64 * n, nvis - 1);
            AT_COMMIT(cb ^ 1, true);
            __syncthreads(); cb ^= 1; }
        const float g_c = sigmoid_f(p.GATE()[(size_t)m * 256 + h * 3 + 0]);
#pragma unroll
        for (int dt = 0; dt < 8; ++dt) res[dt] = oa[dt] * g_c;
    }
    unsigned long long selm0, selm1;
    {
        unsigned long long sm[2];
#pragma unroll
        for (int q2 = 0; q2 < 2; ++q2) { const int tq = t0 + q2, s = lane, cur = tq >> 6; float a = 0.f;
#pragma unroll
            for (int dn = -1; dn <= 3; ++dn) { const int n = 4 * s + dn; if (n >= 0 && n < 255) a += ps[q2 * 256 + n]; }
            const bool causal = s <= cur, forced = (s == 0) || (s == cur) || (s == cur - 1);
            const float score = causal ? a + (forced ? 1e4f : 0.f) : -1e30f; int rank = 0;
#pragma unroll 8
            for (int s2 = 0; s2 < 64; ++s2) { const float v2 = __shfl(score, s2); rank += ((v2 > score) || (v2 == score && s2 < s)) ? 1 : 0; }
            sm[q2] = __ballot(rank < 16 && causal); }
        selm0 = sm[0]; selm1 = sm[1];
    }
    const unsigned long long myU = selm0 | selm1;
    if (lane == 0) *(LAS unsigned long long*)(lds + AT_UM + wave * 8) = myU;
    __syncthreads();
    unsigned long long U = 0ull;
#pragma unroll
    for (int w = 0; w < 8; ++w) U |= *(const LAS unsigned long long*)(lds + AT_UM + w * 8);
    U = __builtin_amdgcn_readfirstlane((unsigned)U) | ((unsigned long long)__builtin_amdgcn_readfirstlane((unsigned)(U >> 32)) << 32);
    const GAS bf16* kbS = (const GAS bf16*)p.KSLC() + (size_t)(bg * 4096) * 128;
    const GAS bf16* vtbS = (const GAS bf16*)p.VSLCT() + (size_t)(bg * 64) * 8192;
    {
#pragma unroll
        for (int dt = 0; dt < 8; ++dt) oa[dt] = (f32x4){0.f, 0.f, 0.f, 0.f};
        l_run = 0.f;
        const int s_first = __builtin_ctzll(U);
        for (int n = 0; n < w_nb; ++n) { const int s = w_lo + n;
            if (n + 1 < w_nb) AT_ISSUE(kbW + (size_t)(s + 1) * 8192, vtbW + (size_t)(s + 1) * 8192, true); else AT_ISSUE(kbS + (size_t)s_first * 8192, vtbS + (size_t)s_first * 8192, true);
            if (64 * s + 63 >= t0 - 511 && 64 * s <= t0 + 1) { if (64 * s >= t0 - 510 && 64 * s + 63 <= t0) AT_STEP_ONLINE(cb, 64 * s, 1, true, 0, 0); else AT_STEP_ONLINE(cb, 64 * s, 0, true, t - 511, t); }
            AT_COMMIT(cb ^ 1, true);
            __syncthreads(); cb ^= 1; }
        float lt = l_run; lt += __shfl_xor(lt, 16); lt += __shfl_xor(lt, 32); const float f = sigmoid_f(p.GATE()[(size_t)m * 256 + h * 3 + 2]) / lt;
#pragma unroll
        for (int dt = 0; dt < 8; ++dt) res[dt] += oa[dt] * f;
    }
    {
#pragma unroll
        for (int dt = 0; dt < 8; ++dt) oa[dt] = (f32x4){0.f, 0.f, 0.f, 0.f};
        l_run = 0.f;
        const unsigned long long mym = qi ? selm1 : selm0;
        int s = __builtin_ctzll(U); U &= U - 1;
        for (;;) { const bool more = U != 0ull; const int sn = more ? __builtin_ctzll(U) : 0; U &= U - 1;
            if (more) AT_ISSUE(kbS + (size_t)sn * 8192, vtbS + (size_t)sn * 8192, true);
            if ((myU >> s) & 1ull) { const bool rowsel = (mym >> s) & 1ull;
                if (64 * s + 63 <= t0) AT_STEP_ONLINE(cb, 64 * s, 1, rowsel, 0, 0); else AT_STEP_ONLINE(cb, 64 * s, 0, rowsel, 0, t); }
            if (more) AT_COMMIT(cb ^ 1, true);
            __syncthreads(); cb ^= 1;
            if (!more) break;
            s = sn; }
        float lt = l_run; lt += __shfl_xor(lt, 16); lt += __shfl_xor(lt, 32); const float f = sigmoid_f(p.GATE()[(size_t)m * 256 + h * 3 + 1]) / lt;
#pragma unroll
        for (int dt = 0; dt < 8; ++dt) res[dt] += oa[dt] * f;
    }
    bf16* op = p.OB() + (size_t)m * 2048 + h * 128 + 4 * c;
#pragma unroll
    for (int dt = 0; dt < 8; ++dt) { u32x2 w; w.x = pk2(res[dt][0], res[dt][1]); w.y = pk2(res[dt][2], res[dt][3]); *(GAS u32x2*)(op + 16 * dt) = w; }
}

template <int KIND> __device__ __forceinline__ void sample_attn(const Params& p, int item, LAS unsigned char* lds) {
    constexpr int NK = KIND == 2 ? 1024 : 512, KPW = NK / 8;
    const int b = item >> 1, g = item & 1, tid = tid_opaque(), wave = tid >> 6, lane = tid & 63;
    LAS float* Qf = (LAS float*)lds;
    LAS float* S = (LAS float*)(lds + 4096);
    LAS float* PT = (LAS float*)(lds + 4096 + 32768);
    LAS float* R = (LAS float*)(lds + 4096 + 65536);
    LAS float* IMP = (LAS float*)(lds + 4096 + 98304);
    LAS int* FLG = (LAS int*)(lds + 4096 + 98304 + 640);
    LAS int* SELL = (LAS int*)(lds + 4096 + 98304 + 1280);
    const float scale = 0.08838834764831845f;
    for (int idx = tid; idx < 1024; idx += NT) Qf[idx] = p.QS()[(size_t)b * 2048 + g * 1024 + idx];
    if (KIND == 2 && tid < 16) SELL[tid] = p.SELG()[item * 16 + tid];
    __syncthreads();
    const float* sbase0 = nullptr; const float* sbase1 = nullptr; bool snew0 = false, snew1 = false;
    if constexpr (KIND == 2) {
        const int sa = SELL[2 * wave], sb2 = SELL[2 * wave + 1]; snew0 = sa >= 128; snew1 = sb2 >= 128;
        const int pa = p.ptab()[b * NPAGE + (snew0 ? 0 : sa >> 1)], pb = p.ptab()[b * NPAGE + (snew1 ? 0 : sb2 >> 1)];
        sbase0 = snew0 ? p.out + O_KVS + (size_t)b * 1024 + 512 + g * 128 : p.cache() + ((size_t)pa * 128 + (sa & 1) * 64) * 1024 + 512 + g * 128;
        sbase1 = snew1 ? p.out + O_KVS + (size_t)b * 1024 + 512 + g * 128 : p.cache() + ((size_t)pb * 128 + (sb2 & 1) * 64) * 1024 + 512 + g * 128; }
    if constexpr (KIND == 0) {
        const int n = wave * 64 + lane; float sc[8];
#pragma unroll
        for (int hh = 0; hh < 8; ++hh) sc[hh] = 0.f;
        const GAS f32x4* kr = (const GAS f32x4*)(p.KCS() + ((size_t)(b * 2 + g) * 512 + (n < 511 ? n : 510)) * 128);
#pragma unroll 4
        for (int d4 = 0; d4 < 32; ++d4) { const f32x4 kv = kr[d4];
#pragma unroll
            for (int hh = 0; hh < 8; ++hh) { const f32x4 qv = *(const LAS f32x4*)(Qf + hh * 128 + 4 * d4); sc[hh] += (kv.x * qv.x + kv.y * qv.y) + (kv.z * qv.z + kv.w * qv.w); } }
#pragma unroll
        for (int hh = 0; hh < 8; ++hh) S[hh * NK + n] = n < 511 ? sc[hh] * scale : -1e30f;
    } else {
        const int c = lane >> 4, j = lane & 15;
        bf16x8 qf[4];
#pragma unroll
        for (int kk = 0; kk < 4; ++kk) { f32x4 a = {0.f, 0.f, 0.f, 0.f}, bq = {0.f, 0.f, 0.f, 0.f};
            if (j < 8) { a = *(const LAS f32x4*)(Qf + j * 128 + 32 * kk + 8 * c); bq = *(const LAS f32x4*)(Qf + j * 128 + 32 * kk + 8 * c + 4); }
            qf[kk] = pack_p(a, bq); }
        for (int tb = 0; tb < KPW / 16; tb += 4) {
            f32x4 x0[4][4], x1[4][4]; bool vld[4];
#pragma unroll
            for (int u = 0; u < 4; ++u) { const int tl = tb + u; const int slot = wave * KPW + tl * 16 + j; const float* kr; bool valid = true;
                if constexpr (KIND == 1) { kr = slot < 511 ? p.state() + ((size_t)b * 512 + slot + 1) * 512 + g * 128 : p.out + O_WINS + ((size_t)b * 512 + 511) * 512 + g * 128; }
                else { const int kq = slot & 63; const bool hi = (tl >= 4);
                    const float* bb = hi ? sbase1 : sbase0; const bool nw = hi ? snew1 : snew0; valid = !nw || kq == 0; kr = bb + (nw ? 0 : kq * 1024); }
                vld[u] = valid;
#pragma unroll
                for (int kk = 0; kk < 4; ++kk) { x0[u][kk] = *(const GAS f32x4*)(kr + 32 * kk + 8 * c); x1[u][kk] = *(const GAS f32x4*)(kr + 32 * kk + 8 * c + 4); } }
#pragma unroll
            for (int u = 0; u < 4; ++u) { const int tl = tb + u; f32x4 acc = {0.f, 0.f, 0.f, 0.f};
#pragma unroll
                for (int kk = 0; kk < 4; ++kk) acc = MFMA16(pack_p(x0[u][kk], x1[u][kk]), qf[kk], acc);
#pragma unroll
                for (int e = 0; e < 4; ++e) { const bool v = __shfl((int)vld[u], 4 * c + e) != 0; if (j < 8) S[j * NK + wave * KPW + tl * 16 + 4 * c + e] = v ? acc[e] * scale : -1e30f; } } }
    }
    __syncthreads();
    { float vals[NK / 64]; float mx = -1e30f;
#pragma unroll
      for (int k = 0; k < NK / 64; ++k) { vals[k] = S[wave * NK + lane + 64 * k]; mx = fmaxf(mx, vals[k]); }
      mx = wave_max(mx); float sum = 0.f;
#pragma unroll
      for (int k = 0; k < NK / 64; ++k) { vals[k] = vals[k] > -0.5e30f ? __expf(vals[k] - mx) : 0.f; sum += vals[k]; }
      sum = wave_sum(sum); const float inv = 1.0f / sum;
#pragma unroll
      for (int k = 0; k < NK / 64; ++k) PT[(lane + 64 * k) * 8 + wave] = vals[k] * inv; }
    __syncthreads();
    { float a0[8], a1[8];
#pragma unroll
      for (int hh = 0; hh < 8; ++hh) { a0[hh] = 0.f; a1[hh] = 0.f; }
      for (int kb = 0; kb < KPW; kb += 32) {
          f32x2 vv[32];
#pragma unroll
          for (int u = 0; u < 32; ++u) { const int kq = kb + u, slot = wave * KPW + kq; const float* vr;
              if constexpr (KIND == 0) vr = p.VCS() + ((size_t)(b * 2 + g) * 512 + (slot < 511 ? slot : 510)) * 128;
              else if constexpr (KIND == 1) vr = slot < 511 ? p.state() + ((size_t)b * 512 + slot + 1) * 512 + 256 + g * 128 : p.out + O_WINS + ((size_t)b * 512 + 511) * 512 + 256 + g * 128;
              else { const int k6 = slot & 63; const bool hi = kq >= 64; vr = (hi ? sbase1 : sbase0) + 256 + ((hi ? snew1 : snew0) ? 0 : k6 * 1024); }
              vv[u] = *(const GAS f32x2*)(vr + 2 * lane); }
#pragma unroll
          for (int u = 0; u < 32; ++u) { const int slot = wave * KPW + kb + u; const f32x2 v = vv[u]; const f32x4 p0 = *(const LAS f32x4*)(PT + slot * 8), p1 = *(const LAS f32x4*)(PT + slot * 8 + 4);
              a0[0] += p0.x * v.x; a1[0] += p0.x * v.y; a0[1] += p0.y * v.x; a1[1] += p0.y * v.y; a0[2] += p0.z * v.x; a1[2] += p0.z * v.y; a0[3] += p0.w * v.x; a1[3] += p0.w * v.y;
              a0[4] += p1.x * v.x; a1[4] += p1.x * v.y; a0[5] += p1.y * v.x; a1[5] += p1.y * v.y; a0[6] += p1.z * v.x; a1[6] += p1.z * v.y; a0[7] += p1.w * v.x; a1[7] += p1.w * v.y; } }
#pragma unroll
      for (int hh = 0; hh < 8; ++hh) *(LAS f32x2*)(R + (wave * 8 + hh) * 128 + 2 * lane) = (f32x2){a0[hh], a1[hh]}; }
    if constexpr (KIND == 0) {
        if (tid < 129) { const int s = tid; float a = 0.f;
            for (int dn = -1; dn <= 3; ++dn) { const int n = 4 * s + dn; if (n >= 0 && n < 511) { const f32x4 x = *(const LAS f32x4*)(PT + n * 8), y = *(const LAS f32x4*)(PT + n * 8 + 4); a += ((x.x + x.y) + (x.z + x.w)) + ((y.x + y.y) + (y.z + y.w)); } }
            IMP[s] = a + ((s == 0 || s >= 127) ? 1e4f : 0.f); }
    }
    __syncthreads();
    if constexpr (KIND == 0) {
        if (tid < 129) { const float v = IMP[tid]; int rank = 0; for (int s2 = 0; s2 < 129; ++s2) { const float v2 = IMP[s2]; rank += ((v2 > v) || (v2 == v && s2 < tid)) ? 1 : 0; } FLG[tid] = rank < 16 ? 1 : 0; }
    }
    { const int hh = tid >> 6, hq = g * 8 + hh; f32x2 o = {0.f, 0.f};
#pragma unroll
      for (int w = 0; w < 8; ++w) { const f32x2 x = *(const LAS f32x2*)(R + (w * 8 + hh) * 128 + 2 * lane); o.x += x.x; o.y += x.y; }
      const float gt = p.GS()[b * 48 + hq * 3 + (KIND == 0 ? 0 : KIND == 1 ? 2 : 1)]; const size_t oo = (size_t)b * 2048 + hq * 128 + 2 * lane;
      if constexpr (KIND == 0) *(GAS f32x2*)(p.OSFC() + oo) = o * gt;
      else if constexpr (KIND == 1) *(GAS f32x2*)(p.OSFW() + oo) = o * gt;
      else { const f32x2 oc = *(const GAS f32x2*)(p.OSFC() + oo), ow = *(const GAS f32x2*)(p.OSFW() + oo); *(GAS unsigned*)(p.OSB() + oo) = pk2(oc.x + ow.x + o.x * gt, oc.y + ow.y + o.y * gt); } }
    __syncthreads();
    if constexpr (KIND == 0) { if (tid < 129 && FLG[tid]) { int idx = 0; for (int s2 = 0; s2 < tid; ++s2) idx += FLG[s2]; if (idx < 16) p.SELG()[item * 16 + idx] = tid; } }
    __syncthreads();
}
#ifndef PROBE_MASK
#define PROBE_MASK 0
#endif

constexpr int NPHASE = 14;
template <int PH> __device__ __forceinline__ void run_phase(const Params& p, LAS unsigned char* lds) {
    const int tid = tid_opaque(), wave = tid >> 6, lane = tid & 63, G = gridDim.x; const int gw = blockIdx.x * 8 + wave, NGW = G * 8;
    if constexpr (PH == 0) { phase0(p, lds); }
    if constexpr (PH == 1) {
        if (blockIdx.x == 0 && tid < 256) { float a[32];
#pragma unroll
            for (int rr = 0; rr < 32; ++rr) a[rr] = p.CBIAS()[((tid >> 7) * 32 + rr) * 128 + (tid & 127)];
            float sacc = 0.f;
#pragma unroll
            for (int rr = 0; rr < 32; ++rr) sacc += a[rr];
            p.CBIASF()[tid] = sacc; }
        if ((blockIdx.x >> 2) & 1) cmp_stream_gemm(p, lds);
        { pg8::Gemm g{p.XB(), p.W_ain(), MP, 4096, 2048, 2048, 2048}; pg8::StaticOrder S; S.init(MP, 4096, G, (int)blockIdx.x); EpiA1 E{p.U(), p.V(), p.x_ssq(), p.v_ssq()};
          pg8::gemm_phase<EpiA1, pg8::StaticOrder, true, true>(lds, g, S, E); }
        if (!((blockIdx.x >> 2) & 1)) cmp_stream_gemm(p, lds);
        { SkEpi e{1, p.xs_ssq(), p.US(), p.VS(), nullptr, nullptr, nullptr}; skinny_gemm(lds, p.XSB(), 2048, p.W_ain(), 4096, e); }
    }
    if constexpr (PH == 2) {
        if constexpr ((PROBE_MASK >> 21) & 1) { cmp_stream_gemm(p, lds); __syncthreads(); }
        gating_block(p, lds);
        for (int i = gw; i < MS; i += NGW) sample_gating_row(p, i, lane);
        __syncthreads();
        cmp_w2_to_lds(p, lds); __syncthreads();
        for (int it = gw; it < 64 * 32; it += NGW) { const int bg = it >> 5, i0 = (it & 31) * 16; const size_t r0 = (size_t)bg * 512 + i0;
            f32x4 kc[8], vc[8]; cmp_finish16<1>(p.FCMPS() + r0 * 256, p.FCMPS() + (32768 + r0) * 256, 0, i0, 511, lds, p.k_norm(), p.ROPE(), lane, kc, vc);
            const int c = lane >> 4, j = lane & 15;
            if (i0 + j < 511) {
#pragma unroll
                for (int dt = 0; dt < 8; ++dt) { *(GAS f32x4*)(p.KCS() + (r0 + j) * 128 + 16 * dt + 4 * c) = kc[dt]; *(GAS f32x4*)(p.VCS() + (r0 + j) * 128 + 16 * dt + 4 * c) = vc[dt]; } } }
        __syncthreads();
    }
    if constexpr (PH == 3) {
        { pg8::Gemm g{p.GT(), p.W_aout(), MP, 2048, 2048, 2048, 2048}; pg8::StaticOrder S; S.init(MP, 2048, G, (int)blockIdx.x); EpiRes E{p.x_p(), p.H1(), p.H1B(), p.h1_ssq()};
          pg8::gemm_phase<EpiRes, pg8::StaticOrder, true, true>(lds, g, S, E); }
        { SkEpi e{2, nullptr, p.H1S(), nullptr, p.x_s(), p.H1SB(), p.h1s_ssq()}; skinny_gemm(lds, p.GTS(), 2048, p.W_aout(), 2048, e); }
    }
    if constexpr (PH == 4 || PH == 12) {
        const bool l1 = PH == 12;
        { pg8::Gemm g{l1 ? p.H3B() : p.H1B(), l1 ? p.W_up1() : p.W_up0(), MP, 8192, 2048, 2048, 2048}; pg8::StaticOrder S; S.init(MP, 8192, G, (int)blockIdx.x); EpiUp E{p.ACT(), 8192, l1 ? p.h3_ssq() : p.h1_ssq()};
          pg8::gemm_phase<EpiUp, pg8::StaticOrder, true, true>(lds, g, S, E); }
        { SkEpi e{3, l1 ? p.h3s_ssq() : p.h1s_ssq(), nullptr, nullptr, nullptr, p.ACTS(), nullptr}; skinny_gemm(lds, l1 ? p.H3SB() : p.H1SB(), 2048, l1 ? p.W_up1() : p.W_up0(), 8192, e); }
    }
    if constexpr (PH == 5) {
        { pg8::Gemm g{p.ACT(), p.W_dn0(), MP, 2048, 8192, 8192, 8192}; pg8::StaticOrder S; S.init(MP, 2048, G, (int)blockIdx.x); EpiRes E{p.H1(), p.H2(), p.H2B(), p.h2_ssq()};
          pg8::gemm_phase<EpiRes, pg8::StaticOrder, true, true>(lds, g, S, E); }
        { SkEpi e{2, nullptr, p.H2S(), nullptr, p.H1S(), p.H2SB(), p.h2s_ssq()}; skinny_gemm(lds, p.ACTS(), 8192, p.W_dn0(), 2048, e); }
    }
    if constexpr (PH == 6) {
        { pg8::Gemm g{p.H2B(), p.W_kvq(), MP, NKVQ, 2048, 2048, 2048}; pg8::StaticOrder S; S.init(MP, NKVQ, G, (int)blockIdx.x); EpiKvq E{p.out + O_KVP, p.WINF(), p.QRAW(), p.GATE(), p.h2_ssq(), p.ACMP()};
          pg8::gemm_phase<EpiKvq, pg8::StaticOrder, true, true>(lds, g, S, E); }
        { SkEpi e{0, p.h2s_ssq(), p.KVQS(), nullptr, nullptr, nullptr, nullptr}; skinny_gemm(lds, p.H2SB(), 2048, p.W_kvq(), NKVQ, e, G - 32); }
    }
    if constexpr (PH == 7) {
        unsigned* hand = p.bar() + 8192;
        if (blockIdx.x < 32) { const int ks = (int)blockIdx.x >> 3;
          pg8::Gemm g{p.ACMP() + ks * 512, p.W_cmp() + ks * 512, 2048, 512, 512, 2048, 2048}; pg8::DiagOrder S{8, 4, 8, (int)blockIdx.x & 7}; EpiPlain E{p.FCMP8() + (size_t)ks * 2048 * 256};
          pg8::gemm_phase<EpiPlain, pg8::DiagOrder, true, true>(lds, g, S, E);
          VM_WAIT(); __syncthreads();
          if (tid == 0) { __builtin_amdgcn_fence(__ATOMIC_RELEASE, "agent"); asm volatile("s_waitcnt vmcnt(0)" ::: "memory"); __hip_atomic_fetch_add(hand + 64 * 64, 1u, __ATOMIC_RELAXED, __HIP_MEMORY_SCOPE_AGENT); } }
        { FinRow ra, rb; int m = gw;
          if (m < MP) finish_row_load(p, m, lane, ra);
          while (m < MP) { const int m1 = m + NGW; if (m1 < MP) finish_row_load(p, m1, lane, rb);
              finish_row_prompt(p, m, lane, ra);
              if (m1 >= MP) break;
              const int m2 = m1 + NGW; if (m2 < MP) finish_row_load(p, m2, lane, ra);
              finish_row_prompt(p, m1, lane, rb);
              m = m2; } }
        for (int it = blockIdx.x; it < 512; it += G) vt_item(p, it, lds);
        __syncthreads();
        if (blockIdx.x < 32) {
          if (blockIdx.x < 8) {
            if (tid < 64) { unsigned spins = 0; while (__builtin_amdgcn_readfirstlane(__hip_atomic_load(hand + 64 * 64, __ATOMIC_RELAXED, __HIP_MEMORY_SCOPE_AGENT)) < 32u && ++spins < (1u << 20)) __builtin_amdgcn_s_sleep(2);
                __builtin_amdgcn_fence(__ATOMIC_ACQUIRE, "agent"); asm volatile("s_waitcnt vmcnt(0)" ::: "memory"); }
            __syncthreads();
        cmp_w2_to_lds(p, lds);
        if (blockIdx.x < 8) {
            const size_t R0 = (size_t)blockIdx.x * 128;
            for (int half = 0; half < 2; ++half) for (int o0 = 0; o0 < 129 * 64; o0 += NT * 8) { f32x4 acc4[8];
#pragma unroll
                for (int k = 0; k < 8; ++k) { const int o = o0 + tid + NT * k; acc4[k] = (f32x4){0.f, 0.f, 0.f, 0.f};
                    if (o < 129 * 64 && R0 + (o >> 6) < 1024) { const float* src = p.FCMP8() + ((size_t)half * 1024 + R0 + (o >> 6)) * 256 + (o & 63) * 4;
                        acc4[k] = (*(const GAS f32x4*)src + *(const GAS f32x4*)(src + (size_t)2048 * 256)) + (*(const GAS f32x4*)(src + (size_t)2 * 2048 * 256) + *(const GAS f32x4*)(src + (size_t)3 * 2048 * 256)); } }
#pragma unroll
                for (int k = 0; k < 8; ++k) { const int o = o0 + tid + NT * k; if (o < 129 * 64 && R0 + (o >> 6) < 1024) *(GAS f32x4*)(p.FCMP() + ((size_t)half * 1024 + R0 + (o >> 6)) * 256 + (o & 63) * 4) = acc4[k]; } }
            VM_WAIT(); }
        __syncthreads();
        for (int it = gw; it < 4 * 16; it += NGW) { const int bg = it >> 4, i0 = (it & 15) * 16; const size_t r0 = (size_t)bg * 256 + i0;
            f32x4 kc[8], vc[8]; cmp_finish16<1>(p.FCMP() + r0 * 256, p.FCMP() + (1024 + r0) * 256, 0, i0, 255, lds, p.k_norm(), p.ROPE(), lane, kc, vc);
            const int c = lane >> 4, j = lane & 15, i = i0 + j; const bool ok = i < 255;
#pragma unroll
            for (int dt = 0; dt < 8; ++dt) { const f32x4 kk4 = ok ? kc[dt] : (f32x4){0.f, 0.f, 0.f, 0.f}, vv4 = ok ? vc[dt] : (f32x4){0.f, 0.f, 0.f, 0.f};
                u32x2 w; w.x = pk2(kk4[0], kk4[1]); w.y = pk2(kk4[2], kk4[3]); *(GAS u32x2*)(p.KC() + (r0 + j) * 128 + 16 * dt + 4 * c) = w;
                bf16* vt = p.VCT() + ((size_t)(bg * 4 + (i >> 6)) * 128 + 16 * dt + 4 * c) * 64 + (i & 63);
                vt[0] = (bf16)f2bf(vv4[0]); vt[64] = (bf16)f2bf(vv4[1]); vt[128] = (bf16)f2bf(vv4[2]); vt[192] = (bf16)f2bf(vv4[3]); } }
        __syncthreads();
          }
        } else if (blockIdx.x < 160) { const bool isw = blockIdx.x >= 96; const int item = (int)blockIdx.x - (isw ? 96 : 32);
            if (tid < 64) finish_row_sample(p, item >> 1, lane);
            VM_WAIT(); __syncthreads();
            if (!isw) {
                sample_attn<0>(p, item, lds);
                VM_WAIT(); __syncthreads();
                if (tid < 64) { unsigned* flag = hand + item * 64; unsigned spins = 0;
                    while (__builtin_amdgcn_readfirstlane(__hip_atomic_load(flag, __ATOMIC_RELAXED, __HIP_MEMORY_SCOPE_AGENT)) == 0u && ++spins < (1u << 20)) __builtin_amdgcn_s_sleep(2);
                    __builtin_amdgcn_fence(__ATOMIC_ACQUIRE, "agent"); asm volatile("s_waitcnt vmcnt(0)" ::: "memory"); }
                __syncthreads();
                sample_attn<2>(p, item, lds);
            } else {
                sample_attn<1>(p, item, lds);
                VM_WAIT(); __syncthreads();
                if (tid == 0) { __builtin_amdgcn_fence(__ATOMIC_RELEASE, "agent"); asm volatile("s_waitcnt vmcnt(0)" ::: "memory"); __hip_atomic_store(hand + item * 64, 1u, __ATOMIC_RELAXED, __HIP_MEMORY_SCOPE_AGENT); }
                late_weights(p, lds, 0, 2 * (G - 160) + item, 2 * (G - 160) + 64); late_weights(p, lds, 1, 2 * (G - 160) + item, 2 * (G - 160) + 64); }
        } else { const int k = (int)blockIdx.x - 160, nv = 2 * (G - 160) + 64;
            late_weights(p, lds, 0, 2 * k, nv); late_weights(p, lds, 0, 2 * k + 1, nv); late_weights(p, lds, 1, 2 * k, nv); late_weights(p, lds, 1, 2 * k + 1, nv); }
    }
    if constexpr (PH == 10) {
        for (int bi = blockIdx.x; bi < 1024; bi += G) { const int tile = bi >> 2, bg = bi & 3; attn_prompt_unit(p, bg >> 1, bg & 1, tile * 16, lds, tid); }
    }
    if constexpr (PH == 11) {
        { pg8::Gemm g{p.OB(), p.W_bout(), MP, 2048, 2048, 2048, 2048}; pg8::StaticOrder S; S.init(MP, 2048, G, (int)blockIdx.x); EpiRes E{p.H2(), p.H3(), p.H3B(), p.h3_ssq()};
          pg8::gemm_phase<EpiRes, pg8::StaticOrder, true, true>(lds, g, S, E); }
        { SkEpi e{2, nullptr, p.H3S(), nullptr, p.H2S(), p.H3SB(), p.h3s_ssq()}; skinny_gemm(lds, p.OSB(), 2048, p.W_bout(), 2048, e); }
    }
    if constexpr (PH == 13) {
        { pg8::Gemm g{p.ACT(), p.W_dn1(), MP, 2048, 8192, 8192, 8192}; pg8::StaticOrder S; S.init(MP, 2048, G, (int)blockIdx.x); EpiRes E{p.H3(), p.out + O_YP, nullptr, nullptr};
          pg8::gemm_phase<EpiRes, pg8::StaticOrder, true, true>(lds, g, S, E); }
        { SkEpi e{2, nullptr, p.out + O_YS, nullptr, p.H3S(), nullptr, nullptr}; skinny_gemm(lds, p.ACTS(), 8192, p.W_dn1(), 2048, e); }
    }
}

#ifndef MK_N_LAUNCHES
#define MK_N_LAUNCHES 1
#endif
#if MK_N_LAUNCHES != 1
template <int PH> __global__ void __launch_bounds__(NT, 2) k_phase(Params p) {
    extern __shared__ __attribute__((aligned(16))) unsigned char lds_raw[];
    run_phase<PH>(p, (LAS unsigned char*)lds_raw);
}
template <int PH> static void launch_phase(const Params& p, int grid, hipStream_t stream) {
    static bool attr = false;
    if (!attr) { (void)hipFuncSetAttribute((const void*)k_phase<PH>, hipFuncAttributeMaxDynamicSharedMemorySize, LDS_BYTES); attr = true; }
    hipLaunchKernelGGL(k_phase<PH>, dim3(grid), dim3(NT), LDS_BYTES, stream, p);
}
template <int PH> static void launch_all(const Params& p, int grid, hipStream_t stream) {
    launch_phase<PH>(p, grid, stream);
    if constexpr (PH + 1 < NPHASE) launch_all<PH + 1>(p, grid, stream);
}
#else
#define GRID_BAR() do { XcdBarrier b_; b_.bar = p.bar(); b_.x = xb_xcc_id(); b_.st = (volatile LAS unsigned*)(lds + MISC_OFF); xcd_barrier(b_); } while (0)
#define RUNP(k) do { run_phase<k>(p, lds); if constexpr ((PROBE_MASK >> k) & 1) { GRID_BAR(); run_phase<k>(p, lds); } } while (0)
__global__ void __launch_bounds__(NT, 2) k_mega(Params p) {
    extern __shared__ __attribute__((aligned(16))) unsigned char lds_raw[];
    LAS unsigned char* lds = (LAS unsigned char*)lds_raw;
    if (threadIdx.x < 4) ((LAS unsigned*)(lds + MISC_OFF))[threadIdx.x] = 0u;
    __syncthreads();
    (void)xcd_barrier_post(p.bar(), (volatile LAS unsigned*)(lds + MISC_OFF));
    RUNP(0); GRID_BAR();
    RUNP(1); GRID_BAR();
    RUNP(2); GRID_BAR();
    RUNP(3); GRID_BAR();
    RUNP(4); GRID_BAR();
    RUNP(5); GRID_BAR();
    RUNP(6); GRID_BAR();
    RUNP(7); GRID_BAR();
    RUNP(10); GRID_BAR();
    RUNP(11); GRID_BAR();
    RUNP(12); GRID_BAR();
    RUNP(13);
}
#endif

extern "C" void kernel_launch(void* const* d_in, const int* in_sizes, int n_in, void* d_out, int out_size, void* d_ws, size_t ws_size, hipStream_t stream) {
    (void)in_sizes; (void)n_in; (void)out_size; (void)ws_size;
    Params p{};
    for (int i = 0; i < 24; ++i) p.in[i] = d_in[i];
    p.out = (float*)d_out; p.ws = (unsigned char*)d_ws;
    static int grid = 0;
    if (grid == 0) { int dev = 0, cus = 0; if (hipGetDevice(&dev) != hipSuccess || hipDeviceGetAttribute(&cus, hipDeviceAttributeMultiprocessorCount, dev) != hipSuccess || cus <= 0) cus = 256; grid = cus; }
#if MK_N_LAUNCHES != 1
    launch_all<0>(p, grid, stream);
#else
    static bool attr = false;
    if (!attr) { (void)hipFuncSetAttribute((const void*)k_mega, hipFuncAttributeMaxDynamicSharedMemorySize, LDS_BYTES); attr = true; }
    (void)hipMemsetAsync(d_ws, 0, 65536, stream);
    hipLaunchKernelGGL(k_mega, dim3(grid), dim3(NT), LDS_BYTES, stream, p);
#endif
}
```

```cpp
#include <hip/hip_runtime.h>
#include <cstdio>
#include <cstdint>

#define GAS __attribute__((address_space(1)))
#define LAS __attribute__((address_space(3)))
typedef unsigned short bf16;
typedef short bf16x8 __attribute__((ext_vector_type(8)));
typedef float f32x4 __attribute__((ext_vector_type(4)));
typedef float f32x2 __attribute__((ext_vector_type(2)));
typedef float f32x16 __attribute__((ext_vector_type(16)));
typedef unsigned u32x4 __attribute__((ext_vector_type(4)));
typedef unsigned u32x2 __attribute__((ext_vector_type(2)));

constexpr int D = 2048, T = 4096, MP = 8192, MS = 32, DFF = 8192, NKVQ = 3840, HD = 128;
constexpr int PASTL = 8192, NPAGE = 64;
constexpr float EPS = 1e-6f;
constexpr size_t O_YP = 0, O_YS = 16777216, O_KVP = 16842752, O_WINP = 25231360, O_KVS = 25755648, O_WINS = 25788416, O_VAS = 34177024;
constexpr int LDS_BYTES = 147456;
constexpr int MISC_OFF = 139264;
constexpr int NT = 512;

__device__ __forceinline__ unsigned f2bf(float f) { unsigned u = __builtin_bit_cast(unsigned, f); return (u + 0x7fffu + ((u >> 16) & 1u)) >> 16; }
__device__ __forceinline__ unsigned pk2(float lo, float hi) { unsigned r; asm("v_cvt_pk_bf16_f32 %0, %1, %2" : "=v"(r) : "v"(lo), "v"(hi)); return r; }
__device__ __forceinline__ float readlane_f(float v, int l) { return __builtin_bit_cast(float, __builtin_amdgcn_readlane(__builtin_bit_cast(int, v), l)); }
__device__ __forceinline__ float bf2f(unsigned b) { return __builtin_bit_cast(float, b << 16); }
__device__ __forceinline__ float wave_sum(float v) {
#pragma unroll
    for (int o = 1; o < 64; o <<= 1) v += __shfl_xor(v, o);
    return v;
}
__device__ __forceinline__ float wave_max(float v) {
#pragma unroll
    for (int o = 1; o < 64; o <<= 1) v = fmaxf(v, __shfl_xor(v, o));
    return v;
}
__device__ __forceinline__ float gelu_t(float x) { const float y2 = (2.0f * 0.7978845608028654f * 1.4426950408889634f) * (x + 0.044715f * x * x * x); const float e = __builtin_amdgcn_exp2f(y2); return x - x * __builtin_amdgcn_rcpf(e + 1.f); }
__device__ __forceinline__ float silu_f(float x) { return x * __builtin_amdgcn_rcpf(1.f + __builtin_amdgcn_exp2f(-1.4426950408889634f * x)); }
__device__ __forceinline__ float sigmoid_f(float x) { return __builtin_amdgcn_rcpf(1.f + __builtin_amdgcn_exp2f(-1.4426950408889634f * x)); }
__device__ __forceinline__ int tid_opaque() { int t = threadIdx.x; asm volatile("" : "+v"(t)); return t; }
#define LDS_WAIT() asm volatile("s_waitcnt lgkmcnt(0)" ::: "memory")
#define VM_WAIT() asm volatile("s_waitcnt vmcnt(0)" ::: "memory")

#define XB_TMO      128
#define XB_XCNT(j)  (256  + 64 * (j))
#define XB_XSUB(j)  (1280 + 64 * (j))
#define XB_XGEN(j)  (2304 + 64 * (j))
#define XB_TOP      3328
#define XB_TOPGEN   3392
#define XCD_BAR_WORDS 3456
#define XB_SPIN_CAP (1u << 18)

__device__ __forceinline__ unsigned xb_ld(unsigned* p)              { return __hip_atomic_load(p, __ATOMIC_RELAXED, __HIP_MEMORY_SCOPE_AGENT); }
__device__ __forceinline__ unsigned xb_add(unsigned* p, unsigned v) { return __hip_atomic_fetch_add(p, v, __ATOMIC_RELAXED, __HIP_MEMORY_SCOPE_AGENT); }
__device__ __forceinline__ unsigned xb_xcc_id() { return (unsigned)__builtin_amdgcn_s_getreg((3 << 11) | 20) & 0xFu; }
#define XB_SPIN(cond, bar) do { unsigned _sp = 0; while (cond) { __builtin_amdgcn_s_sleep(1); \
    if ((++_sp & 255u) == 0u) { if (xb_ld(&(bar)[XB_TMO])) break; if (_sp > XB_SPIN_CAP) { atomicAdd(&(bar)[XB_TMO], 1u); break; } } } } while (0)

struct XcdBarrier {
    unsigned* bar; unsigned x;
    volatile LAS unsigned* st;
};

__device__ __forceinline__ XcdBarrier xcd_barrier_post(unsigned* bar, volatile LAS unsigned* st) {
    XcdBarrier b; b.bar = bar; b.x = xb_xcc_id(); b.st = st;
    if (threadIdx.x == 0) (void)xb_add(&bar[XB_XCNT(b.x)], 1u);
    return b;
}
__device__ __forceinline__ void xcd_barrier_complete(unsigned* bar, unsigned x, unsigned& nloc, unsigned& nx) {
    const unsigned G = gridDim.x * gridDim.y * gridDim.z;
    unsigned sum, cnt, mine, sp = 0u;
    for (;;) {
        sum = 0u; cnt = 0u; mine = 0u;
#pragma unroll
        for (unsigned j = 0; j < 16; ++j) { const unsigned c = xb_ld(&bar[XB_XCNT(j)]); sum += c; cnt += (c > 0u) ? 1u : 0u; mine = (j == x) ? c : mine; }
        if (sum == G) break;
        __builtin_amdgcn_s_sleep(1);
        if ((++sp & 255u) == 0u) { if (xb_ld(&bar[XB_TMO])) break; if (sp > XB_SPIN_CAP) { atomicAdd(&bar[XB_TMO], 1u); break; } }
    }
    nloc = mine > 0u ? mine : 1u; nx = cnt > 0u ? cnt : 1u;
}

__device__ __forceinline__ void xcd_barrier(const XcdBarrier& b) {
    asm volatile("s_waitcnt vmcnt(0)" ::: "memory");
    __syncthreads();
    if (threadIdx.x == 0) {
        unsigned* bar = b.bar;
        __builtin_amdgcn_s_waitcnt(0);
        unsigned nloc = b.st[0], nx = b.st[1];
        if (nloc == 0u) { xcd_barrier_complete(bar, b.x, nloc, nx); b.st[0] = nloc; b.st[1] = nx; }
        const unsigned old = xb_add(&bar[XB_XSUB(b.x)], 1u);
        const unsigned gen = old / nloc;
        if (old + 1u == (gen + 1u) * nloc) {
            __builtin_amdgcn_fence(__ATOMIC_RELEASE, "agent");
            asm volatile("s_waitcnt vmcnt(0)" ::: "memory");
            const unsigned og = xb_add(&bar[XB_TOP], 1u);
            const unsigned tg = og / nx;
            if (og + 1u == (tg + 1u) * nx) xb_add(&bar[XB_TOPGEN], 1u);
            else XB_SPIN(xb_ld(&bar[XB_TOPGEN]) == tg, bar);
            __builtin_amdgcn_fence(__ATOMIC_ACQUIRE, "agent");
            xb_add(&bar[XB_XGEN(b.x)], 1u);
            asm volatile("s_waitcnt vmcnt(0)" ::: "memory");
        } else {
            XB_SPIN(xb_ld(&bar[XB_XGEN(b.x)]) == gen, bar);
            __builtin_amdgcn_fence(__ATOMIC_ACQUIRE, "agent");
            asm volatile("s_waitcnt vmcnt(0)" ::: "memory");
        }
    }
    __syncthreads();
}

namespace pg8 {
#define PG8_LAS __attribute__((address_space(3)))
typedef unsigned short bf16_t;
constexpr int BM = 256, BK = 64, HALF = 128, HTB = HALF * BK * 2  , STAGE_BYTES = 8 * HTB, NXCD = 8, WGM = 8;

__host__ __device__ __forceinline__ int lds_byte(int r, int c) { const int st = (r >> 4) * 2 + (c >> 5), rr = r & 15, cc = c & 31, ob = rr * 64 + cc * 2; return st * 1024 + (ob ^ (((ob >> 9) & 1) << 5)); }
__host__ __device__ __forceinline__ void stage_rc(int b, int& R, int& C) { const int st = b / 1024, sb = b % 1024, swz = sb ^ (((sb >> 9) & 1) << 5); R = (st >> 1) * 16 + swz / 64; C = (st & 1) * 32 + (swz % 64) / 2; }
__host__ __device__ __forceinline__ int perm32(int rho) { const int n = rho >> 4, i = rho & 15; return 8 * (i >> 2) + 4 * n + (i & 3); }

struct Unit { int pm, pn; };
struct Gemm { const bf16_t* A; const bf16_t* Bt; int M, N, K, lda, ldb; size_t ksa, ksb; };

struct StaticOrder {
    int nM, nN, nwg, G, c;
    __host__ __device__ void init(int M, int N, int G_, int c_) { nM = M / BM; nN = N / BM; nwg = nM * nN; G = G_; c = c_; }
    __host__ __device__ bool next(int i, Unit& u) const {
        const long L = (long)i * G + c; if (L >= nwg) return false;
        int wgid = (int)L; { const int q = nwg / NXCD, r = nwg % NXCD, xcd = wgid % NXCD, off = wgid / NXCD; wgid = (xcd < r ? xcd * (q + 1) : r * (q + 1) + (xcd - r) * q) + off; }
        const int nig = WGM * nN, gid = wgid / nig, fm = gid * WGM, gsz = (nM - fm) < WGM ? (nM - fm) : WGM;
        u.pm = fm + ((wgid % nig) % gsz); u.pn = (wgid % nig) / gsz; return true;
    }
    __device__ __forceinline__ void a_ready(const Unit&) const {}
    __device__ __forceinline__ void done(const Unit&) const {}
};
struct SplitOrder : StaticOrder {
    int nA, perB;
    __device__ __forceinline__ bool next(int i, Unit& u) const {
        long L; if (c >= nA) { if (i >= perB) return false; L = (long)(c - nA) + (long)(G - nA) * i; } else { if (i >= 1) return false; L = (long)perB * (G - nA) + c; }
        if (L >= nwg) return false;
        int wgid = (int)L; { const int q = nwg / NXCD, r = nwg % NXCD, xcd = wgid % NXCD, off = wgid / NXCD; wgid = (xcd < r ? xcd * (q + 1) : r * (q + 1) + (xcd - r) * q) + off; }
        const int nig = WGM * nN, gid = wgid / nig, fm = gid * WGM, gsz = (nM - fm) < WGM ? (nM - fm) : WGM;
        u.pm = fm + ((wgid % nig) % gsz); u.pn = (wgid % nig) / gsz; return true;
    }
};
struct DiagOrder {
    int nunits, per, G, c;
    __device__ __forceinline__ bool next(int i, Unit& u) const { const int L = i * G + c; if (L >= nunits) return false; u.pm = L; u.pn = L / per; return true; }
    __device__ __forceinline__ void a_ready(const Unit&) const {}
    __device__ __forceinline__ void done(const Unit&) const {}
};

template <class Epi, class Sched, bool ALIGN_EPI = false, bool SP2 = false>
__device__ __forceinline__ void gemm_phase(PG8_LAS unsigned char* lds, const Gemm g, const Sched& S, const Epi& E) {
    const int tid = tid_opaque(), wid = __builtin_amdgcn_readfirstlane(tid >> 6), lane = tid & 63, wr = wid >> 2, wc = wid & 3, fr = lane & 15, fq = lane >> 4;
    const int K = g.K, nt = K / BK;
    unsigned voffA[2], voffB[2];
#pragma unroll
    for (int i = 0; i < 2; ++i) { int R, C; stage_rc(tid * 16 + i * 8192, R, C); const int Rb = Epi::PERM ? ((R & ~31) + perm32(R & 31)) : R;
        voffA[i] = (unsigned)(R * g.lda + C) * 2u; voffB[i] = (unsigned)(Rb * g.ldb + C) * 2u; }
    const size_t kstep = (size_t)(BK * 2);
    const size_t kstepA = g.ksa ? g.ksa : kstep, kstepB = g.ksb ? g.ksb : kstep;
    const size_t hstepA = (size_t)HALF * g.lda * 2, hstepB = (size_t)HALF * g.ldb * 2;
    const size_t tstepA = 2 * hstepA, tstepB = 2 * hstepB;
    const unsigned ldsw = (unsigned)wid * 1024u;
    const int aoff = lds_byte(wr * 64 + fr, fq * 8), boff = lds_byte(wc * 32 + fr, fq * 8);
#define PG8_SA(b, h) (((b) * 2 + (h)) * HTB)
#define PG8_SB(b, h) ((4 + (b) * 2 + (h)) * HTB)
#define PG8_STAGE(bufoff, gbase, voff) do { _Pragma("unroll") for (int _i = 0; _i < 2; ++_i) \
        __builtin_amdgcn_global_load_lds((const unsigned*)((const char*)(gbase) + (voff)[_i]), (PG8_LAS unsigned*)(lds + (bufoff) + ldsw + _i * 8192), 16, 0, 0); } while (0)
#define PG8_LDA(dst, b, h) do { _Pragma("unroll") for (int m = 0; m < 4; ++m) _Pragma("unroll") for (int k = 0; k < 2; ++k) dst[m][k] = *(const PG8_LAS bf16x8*)(lds + PG8_SA(b, h) + aoff + m * 2048 + k * 1024); } while (0)
#define PG8_LDB(dst, b, h) do { _Pragma("unroll") for (int n = 0; n < 2; ++n) _Pragma("unroll") for (int k = 0; k < 2; ++k) dst[n][k] = *(const PG8_LAS bf16x8*)(lds + PG8_SB(b, h) + boff + n * 2048 + k * 1024); } while (0)
#define PG8_MMA(ai, bj, At, Bt) do { __builtin_amdgcn_s_setprio(1); _Pragma("unroll") for (int m = 0; m < 4; ++m) _Pragma("unroll") for (int n = 0; n < 2; ++n) _Pragma("unroll") for (int k = 0; k < 2; ++k) \
        acc[ai][bj][m][n] = __builtin_amdgcn_mfma_f32_16x16x32_bf16(Bt[n][k], At[m][k], acc[ai][bj][m][n], 0, 0, 0); __builtin_amdgcn_s_setprio(0); } while (0)
#define PG8_WAIT_V(n) asm volatile("s_waitcnt vmcnt(" #n ")" ::: "memory")
#define PG8_WAIT_L(n) asm volatile("s_waitcnt lgkmcnt(" #n ")" ::: "memory")
#define PG8_BAR __builtin_amdgcn_s_barrier()
#define PG8_SCHED __builtin_amdgcn_sched_barrier(0)
    Unit cur, nxt; int ui = 0;
    if (!S.next(0, cur)) return;
    f32x4 acc[2][2][4][2];
    E.init(acc, cur, wr, wc, fr, fq);
    bf16x8 At[4][2], B0[2][2], B1[2][2];
    const char* cA = (const char*)g.A + (size_t)cur.pm * tstepA; const char* cB = (const char*)g.Bt + (size_t)cur.pn * tstepB;
    S.a_ready(cur);
    if constexpr (SP2) {
        PG8_STAGE(PG8_SB(0, 0), cB, voffB); PG8_STAGE(PG8_SB(0, 1), cB + hstepB, voffB); PG8_STAGE(PG8_SA(0, 0), cA, voffA); PG8_STAGE(PG8_SA(0, 1), cA + hstepA, voffA);
        if (wr == 1) PG8_BAR;
        PG8_WAIT_V(2); PG8_BAR;
        PG8_STAGE(PG8_SB(1, 0), cB + kstepB, voffB); PG8_STAGE(PG8_SA(1, 0), cA + kstepA, voffA); PG8_STAGE(PG8_SB(1, 1), cB + hstepB + kstepB, voffB);
        PG8_WAIT_V(6); PG8_BAR;
    } else {
        PG8_STAGE(PG8_SB(0, 0), cB, voffB); PG8_STAGE(PG8_SA(0, 0), cA, voffA); PG8_STAGE(PG8_SB(0, 1), cB + hstepB, voffB); PG8_STAGE(PG8_SA(0, 1), cA + hstepA, voffA);
        if (wr == 1) PG8_BAR;
        PG8_WAIT_V(4); PG8_BAR;
        PG8_STAGE(PG8_SB(1, 0), cB + kstepB, voffB); PG8_STAGE(PG8_SA(1, 0), cA + kstepA, voffA); PG8_STAGE(PG8_SB(1, 1), cB + hstepB + kstepB, voffB);
        PG8_WAIT_V(6); PG8_BAR;
    }
    for (;;) {
        const bool has_next = S.next(ui + 1, nxt);
        const char* nA = has_next ? (const char*)g.A + (size_t)nxt.pm * tstepA : cA; const char* nB = has_next ? (const char*)g.Bt + (size_t)nxt.pn * tstepB : cB;
        for (int t = 0; t < nt; t += 2) {
            const bool last = (t == nt - 2);
            const char* a1 = cA + (size_t)(t + 1) * kstepA;
            const char* a2 = last ? nA : cA + (size_t)(t + 2) * kstepA; const char* b2 = last ? nB : cB + (size_t)(t + 2) * kstepB;
            const char* a3 = a2 + kstepA; const char* b3 = b2 + kstepB;
            if (last && has_next) S.a_ready(nxt);
            if constexpr (SP2) {
            PG8_LDB(B0, 0, 0); PG8_LDB(B1, 0, 1); PG8_SCHED; PG8_LDA(At, 0, 0); PG8_STAGE(PG8_SA(1, 1), a1 + hstepA, voffA);
            PG8_WAIT_V(8); PG8_WAIT_L(0); PG8_BAR; PG8_MMA(0, 0, At, B0); PG8_MMA(0, 1, At, B1); PG8_BAR; PG8_SCHED;
            PG8_LDA(At, 0, 1); PG8_STAGE(PG8_SB(0, 0), b2, voffB); PG8_STAGE(PG8_SB(0, 1), b2 + hstepB, voffB); PG8_STAGE(PG8_SA(0, 0), a2, voffA);
            PG8_WAIT_V(8); PG8_WAIT_L(0); PG8_BAR; PG8_MMA(1, 0, At, B0); PG8_MMA(1, 1, At, B1); PG8_BAR; PG8_SCHED;
            PG8_LDB(B0, 1, 0); PG8_LDB(B1, 1, 1); PG8_SCHED; PG8_LDA(At, 1, 0); PG8_STAGE(PG8_SA(0, 1), a2 + hstepA, voffA);
            PG8_WAIT_V(8); PG8_WAIT_L(0); PG8_BAR; PG8_MMA(0, 0, At, B0); PG8_MMA(0, 1, At, B1); PG8_BAR; PG8_SCHED;
            PG8_LDA(At, 1, 1); PG8_STAGE(PG8_SB(1, 0), b3, voffB); PG8_STAGE(PG8_SB(1, 1), b3 + hstepB, voffB); PG8_STAGE(PG8_SA(1, 0), a3, voffA);
            PG8_WAIT_V(8); PG8_WAIT_L(0); PG8_BAR; PG8_MMA(1, 0, At, B0); PG8_MMA(1, 1, At, B1); PG8_BAR; PG8_SCHED;
            } else {
            PG8_LDB(B0, 0, 0); PG8_SCHED; PG8_LDA(At, 0, 0); PG8_STAGE(PG8_SA(1, 1), a1 + hstepA, voffA);
            PG8_WAIT_L(8); PG8_BAR; PG8_WAIT_L(0); PG8_MMA(0, 0, At, B0); PG8_BAR; PG8_SCHED;
            PG8_LDB(B1, 0, 1); PG8_STAGE(PG8_SB(0, 0), b2, voffB);
            PG8_BAR; PG8_WAIT_L(0); PG8_MMA(0, 1, At, B1); PG8_BAR;
            PG8_LDA(At, 0, 1); PG8_STAGE(PG8_SA(0, 0), a2, voffA);
            PG8_BAR; PG8_WAIT_L(0); PG8_MMA(1, 0, At, B0); PG8_BAR; PG8_SCHED;
            PG8_STAGE(PG8_SB(0, 1), b2 + hstepB, voffB);
            PG8_WAIT_V(6); PG8_BAR; PG8_MMA(1, 1, At, B1); PG8_BAR;
            PG8_LDB(B0, 1, 0); PG8_SCHED; PG8_LDA(At, 1, 0); PG8_STAGE(PG8_SA(0, 1), a2 + hstepA, voffA);
            PG8_WAIT_L(8); PG8_BAR; PG8_WAIT_L(0); PG8_MMA(0, 0, At, B0); PG8_BAR; PG8_SCHED;
            PG8_LDB(B1, 1, 1); PG8_STAGE(PG8_SB(1, 0), b3, voffB);
            PG8_BAR; PG8_WAIT_L(0); PG8_MMA(0, 1, At, B1); PG8_BAR;
            PG8_LDA(At, 1, 1); PG8_STAGE(PG8_SA(1, 0), a3, voffA);
            PG8_BAR; PG8_WAIT_L(0); PG8_MMA(1, 0, At, B0); PG8_BAR; PG8_SCHED;
            PG8_STAGE(PG8_SB(1, 1), b3 + hstepB, voffB);
            PG8_WAIT_V(6); PG8_BAR; PG8_MMA(1, 1, At, B1); PG8_BAR;
            }
        }
        if constexpr (ALIGN_EPI) { if (wr == 0) PG8_BAR; }
        E(acc, cur, wr, wc, fr, fq); S.done(cur);
        if (!has_next) break;
        E.init(acc, nxt, wr, wc, fr, fq);
        cur = nxt; cA = nA; cB = nB; ++ui;
        if constexpr (ALIGN_EPI) { if (wr == 1) PG8_BAR; }
    }
    PG8_WAIT_V(0);
    if constexpr (!ALIGN_EPI) { if (wr == 0) PG8_BAR; }
    PG8_BAR;
#undef PG8_SA
#undef PG8_SB
#undef PG8_STAGE
#undef PG8_LDA
#undef PG8_LDB
#undef PG8_MMA
#undef PG8_WAIT_V
#undef PG8_WAIT_L
#undef PG8_BAR
#undef PG8_SCHED
}
}

struct Params {
    const void* in[24]; float* out; unsigned char* ws;
    __device__ __forceinline__ const float* x_p() const { return (const float*)in[0]; }
    __device__ __forceinline__ const float* x_s() const { return (const float*)in[1]; }
    __device__ __forceinline__ const float* cache() const { return (const float*)in[2]; }
    __device__ __forceinline__ const float* state() const { return (const float*)in[3]; }
    __device__ __forceinline__ const int* ptab() const { return (const int*)in[4]; }
    __device__ __forceinline__ const float* a_norm() const { return (const float*)in[5]; }
    __device__ __forceinline__ const float* a_w_in() const { return (const float*)in[6]; }
    __device__ __forceinline__ const float* a_v_norm() const { return (const float*)in[7]; }
    __device__ __forceinline__ const float* a_w_s() const { return (const float*)in[8]; }
    __device__ __forceinline__ const float* a_b_s() const { return (const float*)in[9]; }
    __device__ __forceinline__ const float* a_w_out() const { return (const float*)in[10]; }
    __device__ __forceinline__ const float* mlp_norm() const { return (const float*)in[11]; }
    __device__ __forceinline__ const float* mlp_w_up() const { return (const float*)in[12]; }
    __device__ __forceinline__ const float* mlp_w_down() const { return (const float*)in[13]; }
    __device__ __forceinline__ const float* kv_norm() const { return (const float*)in[14]; }
    __device__ __forceinline__ const float* w_kv() const { return (const float*)in[15]; }
    __device__ __forceinline__ const float* cmp_pe() const { return (const float*)in[16]; }
    __device__ __forceinline__ const float* cmp_w1() const { return (const float*)in[17]; }
    __device__ __forceinline__ const float* cmp_w2() const { return (const float*)in[18]; }
    __device__ __forceinline__ const float* k_norm() const { return (const float*)in[19]; }
    __device__ __forceinline__ const float* b_norm() const { return (const float*)in[20]; }
    __device__ __forceinline__ const float* b_w_in() const { return (const float*)in[21]; }
    __device__ __forceinline__ const float* b_q_norm() const { return (const float*)in[22]; }
    __device__ __forceinline__ const float* b_w_out() const { return (const float*)in[23]; }
    __device__ __forceinline__ unsigned* bar() const { return (unsigned*)(ws + 0ull); }
    __device__ __forceinline__ bf16* W_ain() const { return (bf16*)(ws + 65536ull); }
    __device__ __forceinline__ bf16* W_aout() const { return (bf16*)(ws + 16842752ull); }
    __device__ __forceinline__ bf16* W_up0() const { return (bf16*)(ws + 25231360ull); }
    __device__ __forceinline__ bf16* W_up1() const { return (bf16*)(ws + 58785792ull); }
    __device__ __forceinline__ bf16* W_dn0() const { return (bf16*)(ws + 92340224ull); }
    __device__ __forceinline__ bf16* W_dn1() const { return (bf16*)(ws + 125894656ull); }
    __device__ __forceinline__ bf16* W_kvq() const { return (bf16*)(ws + 159449088ull); }
    __device__ __forceinline__ bf16* W_bout() const { return (bf16*)(ws + 175177728ull); }
    __device__ __forceinline__ bf16* W_cmp() const { return (bf16*)(ws + 183566336ull); }
    __device__ __forceinline__ bf16* XB() const { return (bf16*)(ws + 185663488ull); }
    __device__ __forceinline__ bf16* U() const { return (bf16*)(ws + 219217920ull); }
    __device__ __forceinline__ bf16* V() const { return (bf16*)(ws + 252772352ull); }
    __device__ __forceinline__ bf16* GT() const { return (bf16*)(ws + 286326784ull); }
    __device__ __forceinline__ bf16* H1B() const { return (bf16*)(ws + 319881216ull); }
    __device__ __forceinline__ bf16* ACT() const { return (bf16*)(ws + 353435648ull); }
    __device__ __forceinline__ bf16* H2B() const { return (bf16*)(ws + 487653376ull); }
    __device__ __forceinline__ bf16* QN() const { return (bf16*)(ws + 521207808ull); }
    __device__ __forceinline__ bf16* KSLC() const { return (bf16*)(ws + 554762240ull); }
    __device__ __forceinline__ bf16* KWIN() const { return (bf16*)(ws + 558956544ull); }
    __device__ __forceinline__ bf16* VSLCT() const { return (bf16*)(ws + 563150848ull); }
    __device__ __forceinline__ bf16* VWINT() const { return (bf16*)(ws + 567345152ull); }
    __device__ __forceinline__ bf16* KC() const { return (bf16*)(ws + 571539456ull); }
    __device__ __forceinline__ bf16* VCT() const { return (bf16*)(ws + 571801600ull); }
    __device__ __forceinline__ bf16* OB() const { return (bf16*)(ws + 572063744ull); }
    __device__ __forceinline__ bf16* H3B() const { return (bf16*)(ws + 605618176ull); }
    __device__ __forceinline__ bf16* ACMP() const { return (bf16*)(ws + 639172608ull); }
    __device__ __forceinline__ bf16* ACMPS() const { return (bf16*)(ws + 647561216ull); }
    __device__ __forceinline__ float* x_ssq() const { return (float*)(ws + 915996672ull); }
    __device__ __forceinline__ float* v_ssq() const { return (float*)(ws + 917045248ull); }
    __device__ __forceinline__ float* H1() const { return (float*)(ws + 918093824ull); }
    __device__ __forceinline__ float* h1_ssq() const { return (float*)(ws + 985202688ull); }
    __device__ __forceinline__ float* H2() const { return (float*)(ws + 986251264ull); }
    __device__ __forceinline__ float* h2_ssq() const { return (float*)(ws + 1053360128ull); }
    __device__ __forceinline__ float* WINF() const { return (float*)(ws + 1054408704ull); }
    __device__ __forceinline__ bf16* QRAW() const { return (bf16*)(ws + 1071185920ull); }
    __device__ __forceinline__ float* GATE() const { return (float*)(ws + 1138294784ull); }
    __device__ __forceinline__ float* H3() const { return (float*)(ws + 1146683392ull); }
    __device__ __forceinline__ float* h3_ssq() const { return (float*)(ws + 1213792256ull); }
    __device__ __forceinline__ float* FCMP() const { return (float*)(ws + 1214840832ull); }
    __device__ __forceinline__ float* FCMPS() const { return (float*)(ws + 1216937984ull); }
    __device__ __forceinline__ float* ROPE() const { return (float*)(ws + 1284046848ull); }
    __device__ __forceinline__ float* CBIAS() const { return (float*)(ws + 1285099520ull); }
    __device__ __forceinline__ bf16* XSB() const { return (bf16*)(ws + 1285132288ull); }
    __device__ __forceinline__ bf16* GTS() const { return (bf16*)(ws + 1285263360ull); }
    __device__ __forceinline__ bf16* H1SB() const { return (bf16*)(ws + 1285394432ull); }
    __device__ __forceinline__ bf16* ACTS() const { return (bf16*)(ws + 1285525504ull); }
    __device__ __forceinline__ bf16* H2SB() const { return (bf16*)(ws + 1286049792ull); }
    __device__ __forceinline__ bf16* OSB() const { return (bf16*)(ws + 1286180864ull); }
    __device__ __forceinline__ bf16* H3SB() const { return (bf16*)(ws + 1286311936ull); }
    __device__ __forceinline__ float* xs_ssq() const { return (float*)(ws + 1286443008ull); }
    __device__ __forceinline__ float* US() const { return (float*)(ws + 1286451200ull); }
    __device__ __forceinline__ float* VS() const { return (float*)(ws + 1286713344ull); }
    __device__ __forceinline__ float* H1S() const { return (float*)(ws + 1286975488ull); }
    __device__ __forceinline__ float* h1s_ssq() const { return (float*)(ws + 1287237632ull); }
    __device__ __forceinline__ float* H2S() const { return (float*)(ws + 1287245824ull); }
    __device__ __forceinline__ float* h2s_ssq() const { return (float*)(ws + 1287507968ull); }
    __device__ __forceinline__ float* KVQS() const { return (float*)(ws + 1287516160ull); }
    __device__ __forceinline__ float* QS() const { return (float*)(ws + 1288007680ull); }
    __device__ __forceinline__ float* GS() const { return (float*)(ws + 1288269824ull); }
    __device__ __forceinline__ float* KCS() const { return (float*)(ws + 1288278016ull); }
    __device__ __forceinline__ float* VCS() const { return (float*)(ws + 1305055232ull); }
    __device__ __forceinline__ float* H3S() const { return (float*)(ws + 1321832448ull); }
    __device__ __forceinline__ float* h3s_ssq() const { return (float*)(ws + 1322094592ull); }
    __device__ __forceinline__ float* OSFC() const { return (float*)(ws + 1322102784ull); }
    __device__ __forceinline__ float* OSFW() const { return (float*)(ws + 1322364928ull); }
    __device__ __forceinline__ int* SELG() const { return (int*)(ws + 1322627072ull); }
    __device__ __forceinline__ float* FCMP8() const { return (float*)(ws + 1322631168ull); }
    __device__ __forceinline__ float* CBIASF() const { return (float*)(ws + 1339408384ull); }
};
constexpr size_t WS_TOTAL = 1339412480ull;

__device__ __forceinline__ float row_rs(const float* part, int row, int fq) {
    const GAS f32x4* q = (const GAS f32x4*)(part + (size_t)row * 32 + fq * 8);
    const f32x4 a = q[0], b = q[1];
    float s = ((a.x + a.y) + (a.z + a.w)) + ((b.x + b.y) + (b.z + b.w));
    s += __shfl_xor(s, 16); s += __shfl_xor(s, 32);
    return rsqrtf(s * (1.0f / 2048.0f) + EPS);
}
struct EpiA1 {
    static constexpr bool PERM = true;
    bf16* U; bf16* V; const float* ssq_in; float* vssq;
    __device__ __forceinline__ void init(f32x4 (&acc)[2][2][4][2], const pg8::Unit&, int, int, int, int) const {
#pragma unroll
        for (int a = 0; a < 2; ++a)
#pragma unroll
            for (int b = 0; b < 2; ++b)
#pragma unroll
                for (int m = 0; m < 4; ++m)
#pragma unroll
                    for (int n = 0; n < 2; ++n) acc[a][b][m][n] = (f32x4){0.f, 0.f, 0.f, 0.f}; }
    __device__ __forceinline__ void operator()(const f32x4 (&acc)[2][2][4][2], const pg8::Unit& u, int wr, int wc, int fr, int fq) const {
        const int row0 = u.pm * 256 + wr * 64 + fr; const bool isv = u.pn >= 8;
        bf16* base = isv ? V : U; const int colt = (isv ? u.pn - 8 : u.pn) * 256 + wc * 32 + 8 * fq;
#pragma unroll
        for (int ai = 0; ai < 2; ++ai)
#pragma unroll
            for (int m = 0; m < 4; ++m) { const int row = row0 + ai * 128 + m * 16; const float rs = row_rs(ssq_in, row, fq); float q = 0.f;
                bf16* rowp = base + (size_t)row * 2048 + colt;
#pragma unroll
                for (int bj = 0; bj < 2; ++bj) { f32x4 v0 = acc[ai][bj][m][0] * rs, v1 = acc[ai][bj][m][1] * rs;
#pragma unroll
                    for (int j = 0; j < 4; ++j) { v0[j] = gelu_t(v0[j]); v1[j] = gelu_t(v1[j]); q += v0[j] * v0[j] + v1[j] * v1[j]; }
                    u32x4 w; w.x = pk2(v0[0], v0[1]); w.y = pk2(v0[2], v0[3]); w.z = pk2(v1[0], v1[1]); w.w = pk2(v1[2], v1[3]);
                    *(GAS u32x4*)(rowp + bj * 128) = w; }
                q += __shfl_xor(q, 16); q += __shfl_xor(q, 32);
                if (isv && fq == 0) vssq[(size_t)row * 32 + (u.pn - 8) * 4 + wc] = q; }
    }
};
struct EpiUp {
    static constexpr bool PERM = true;
    bf16* O; int ldc; const float* ssq_in;
    __device__ __forceinline__ void init(f32x4 (&acc)[2][2][4][2], const pg8::Unit&, int, int, int, int) const {
#pragma unroll
        for (int a = 0; a < 2; ++a)
#pragma unroll
            for (int b = 0; b < 2; ++b)
#pragma unroll
                for (int m = 0; m < 4; ++m)
#pragma unroll
                    for (int n = 0; n < 2; ++n) acc[a][b][m][n] = (f32x4){0.f, 0.f, 0.f, 0.f}; }
    __device__ __forceinline__ void operator()(const f32x4 (&acc)[2][2][4][2], const pg8::Unit& u, int wr, int wc, int fr, int fq) const {
        const int row0 = u.pm * 256 + wr * 64 + fr; const int colt = u.pn * 256 + wc * 32 + 8 * fq;
#pragma unroll
        for (int ai = 0; ai < 2; ++ai)
#pragma unroll
            for (int m = 0; m < 4; ++m) { const int row = row0 + ai * 128 + m * 16; const float rs = row_rs(ssq_in, row, fq);
                bf16* rowp = ldc > 0 ? O + (size_t)row * ldc + colt : O + ((size_t)(colt >> 6) * (size_t)(-ldc) + row) * 64 + (colt & 63);
                const size_t bjs = ldc > 0 ? (size_t)128 : (size_t)(-ldc) * 128;
#pragma unroll
                for (int bj = 0; bj < 2; ++bj) { f32x4 v0 = acc[ai][bj][m][0] * rs, v1 = acc[ai][bj][m][1] * rs;
#pragma unroll
                    for (int j = 0; j < 4; ++j) { const float a = fmaxf(v0[j], 0.f), b = fmaxf(v1[j], 0.f); v0[j] = a * a; v1[j] = b * b; }
                    u32x4 w; w.x = pk2(v0[0], v0[1]); w.y = pk2(v0[2], v0[3]); w.z = pk2(v1[0], v1[1]); w.w = pk2(v1[2], v1[3]);
                    *(GAS u32x4*)(rowp + bj * bjs) = w; } }
    }
};
struct EpiRes {
    static constexpr bool PERM = true;
    const float* base; const bf16* baseb; float* out; bf16* ob; float* ssq;
    __device__ __forceinline__ void init(f32x4 (&acc)[2][2][4][2], const pg8::Unit& u, int wr, int wc, int fr, int fq) const {
        const int row0 = u.pm * 256 + wr * 64 + fr, col0 = u.pn * 256 + wc * 32 + 8 * fq;
#pragma unroll
        for (int ai = 0; ai < 2; ++ai)
#pragma unroll
            for (int m = 0; m < 4; ++m) { const size_t off = (size_t)(row0 + ai * 128 + m * 16) * 2048 + col0;
#pragma unroll
                for (int bj = 0; bj < 2; ++bj) {
                    if (baseb) { const u32x4 w = *(const GAS u32x4*)(baseb + off + bj * 128);
                        acc[ai][bj][m][0] = (f32x4){__uint_as_float(w.x << 16), __uint_as_float(w.x & 0xffff0000u), __uint_as_float(w.y << 16), __uint_as_float(w.y & 0xffff0000u)};
                        acc[ai][bj][m][1] = (f32x4){__uint_as_float(w.z << 16), __uint_as_float(w.z & 0xffff0000u), __uint_as_float(w.w << 16), __uint_as_float(w.w & 0xffff0000u)}; }
                    else { acc[ai][bj][m][0] = *(const GAS f32x4*)(base + off + bj * 128); acc[ai][bj][m][1] = *(const GAS f32x4*)(base + off + bj * 128 + 4); } } } }
    __device__ __forceinline__ void operator()(const f32x4 (&acc)[2][2][4][2], const pg8::Unit& u, int wr, int wc, int fr, int fq) const {
        const int row0 = u.pm * 256 + wr * 64 + fr, col0 = u.pn * 256 + wc * 32 + 8 * fq;
#pragma unroll
        for (int ai = 0; ai < 2; ++ai)
#pragma unroll
            for (int m = 0; m < 4; ++m) { const int row = row0 + ai * 128 + m * 16; const size_t off = (size_t)row * 2048 + col0; float q = 0.f;
#pragma unroll
                for (int bj = 0; bj < 2; ++bj) { const f32x4 o0 = acc[ai][bj][m][0], o1 = acc[ai][bj][m][1];
                    if (out) { *(GAS f32x4*)(out + off + bj * 128) = o0; *(GAS f32x4*)(out + off + bj * 128 + 4) = o1; }
                    if (ob) { u32x4 w; w.x = pk2(o0[0], o0[1]); w.y = pk2(o0[2], o0[3]); w.z = pk2(o1[0], o1[1]); w.w = pk2(o1[2], o1[3]); *(GAS u32x4*)(ob + off + bj * 128) = w; }
                    q += ((o0[0] * o0[0] + o0[1] * o0[1]) + (o0[2] * o0[2] + o0[3] * o0[3])) + ((o1[0] * o1[0] + o1[1] * o1[1]) + (o1[2] * o1[2] + o1[3] * o1[3])); }
                q += __shfl_xor(q, 16); q += __shfl_xor(q, 32);
                if (ssq && fq == 0) ssq[(size_t)row * 32 + u.pn * 4 + wc] = q; }
    }
};
struct EpiKvq {
    static constexpr bool PERM = true;
    float *kvp, *winf; bf16* qraw; float* gate; const float* ssq_in; bf16* acmp;
    __device__ __forceinline__ void init(f32x4 (&acc)[2][2][4][2], const pg8::Unit&, int, int, int, int) const {
#pragma unroll
        for (int a = 0; a < 2; ++a)
#pragma unroll
            for (int b = 0; b < 2; ++b)
#pragma unroll
                for (int m = 0; m < 4; ++m)
#pragma unroll
                    for (int n = 0; n < 2; ++n) acc[a][b][m][n] = (f32x4){0.f, 0.f, 0.f, 0.f}; }
    __device__ __forceinline__ void operator()(const f32x4 (&acc)[2][2][4][2], const pg8::Unit& u, int wr, int wc, int fr, int fq) const {
        float* base; int ld, c0;
        if (u.pn < 4) { base = kvp; ld = 1024; c0 = u.pn * 256; } else if (u.pn < 6) { base = winf; ld = 512; c0 = (u.pn - 4) * 256; }
        else if (u.pn < 14) { base = nullptr; ld = 2048; c0 = (u.pn - 6) * 256; } else { base = gate; ld = 256; c0 = 0; }
        const bool isq = u.pn >= 6 && u.pn < 14;
        const int row0 = u.pm * 256 + wr * 64 + fr, col0 = c0 + wc * 32 + 8 * fq;
#pragma unroll
        for (int ai = 0; ai < 2; ++ai)
#pragma unroll
            for (int m = 0; m < 4; ++m) { const int row = row0 + ai * 128 + m * 16; const float rs = row_rs(ssq_in, row, fq); float* rowp = base + (size_t)row * ld + col0;
#pragma unroll
                for (int bj = 0; bj < 2; ++bj) { const f32x4 v0 = acc[ai][bj][m][0] * rs, v1 = acc[ai][bj][m][1] * rs;
                    u32x4 w; w.x = pk2(v0[0], v0[1]); w.y = pk2(v0[2], v0[3]); w.z = pk2(v1[0], v1[1]); w.w = pk2(v1[2], v1[3]);
                    if (isq) *(GAS u32x4*)(qraw + (size_t)row * 2048 + col0 + bj * 128) = w;
                    else { *(GAS f32x4*)(rowp + bj * 128) = v0; *(GAS f32x4*)(rowp + bj * 128 + 4) = v1; }
                    if (u.pn < 2) {
                        const int b = row >> 12, t = row & 4095;
                        *(GAS u32x4*)(acmp + ((size_t)(u.pn * 1024 + (b * 2 + bj) * 256 + (t >> 4))) * 2048 + (t & 15) * 128 + wc * 32 + 8 * fq) = w; } } }
    }
};
struct EpiPlain {
    static constexpr bool PERM = false;
    float* C;
    __device__ __forceinline__ void init(f32x4 (&acc)[2][2][4][2], const pg8::Unit&, int, int, int, int) const {
#pragma unroll
        for (int a = 0; a < 2; ++a)
#pragma unroll
            for (int b = 0; b < 2; ++b)
#pragma unroll
                for (int m = 0; m < 4; ++m)
#pragma unroll
                    for (int n = 0; n < 2; ++n) acc[a][b][m][n] = (f32x4){0.f, 0.f, 0.f, 0.f}; }
    __device__ __forceinline__ void operator()(const f32x4 (&acc)[2][2][4][2], const pg8::Unit& u, int wr, int wc, int fr, int fq) const {
        const int row0 = u.pm * 256 + wr * 64 + fr, col0 = wc * 32 + 4 * fq;
#pragma unroll
        for (int ai = 0; ai < 2; ++ai)
#pragma unroll
            for (int m = 0; m < 4; ++m) { float* rowp = C + (size_t)(row0 + ai * 128 + m * 16) * 256 + col0;
#pragma unroll
                for (int bj = 0; bj < 2; ++bj)
#pragma unroll
                    for (int n = 0; n < 2; ++n) *(GAS f32x4*)(rowp + bj * 128 + n * 16) = acc[ai][bj][m][n]; }
    }
};

struct SkEpi { int mode; const float* ssq_in; float* f0; float* f1; const float* base; bf16* b0; float* ssq_out; };
template <bool BTILED = false>
__device__ __forceinline__ void skinny_gemm(LAS unsigned char* lds, const bf16* A, int K, const bf16* Bt, int N, const SkEpi e, int first = 0) {
    const int tid = tid_opaque(), wave = tid >> 6, lane = tid & 63, G = (int)gridDim.x - first, bx = (int)blockIdx.x - first;
    if (bx < 0 || bx >= N / 32) return;
    LAS float* red = (LAS float*)lds;
    LAS float* rst = (LAS float*)(lds + 8 * 32 * 33 * 4);
    if (e.ssq_in) { const int row = tid >> 4, sub = tid & 15; const GAS f32x4* q = (const GAS f32x4*)(e.ssq_in + row * 64 + sub * 4); const f32x4 a = q[0];
        float s = (a.x + a.y) + (a.z + a.w); s += __shfl_xor(s, 1); s += __shfl_xor(s, 2); s += __shfl_xor(s, 4); s += __shfl_xor(s, 8);
        if (sub == 0) rst[row] = rsqrtf(s * (1.0f / 2048.0f) + EPS); }
    else if (tid < 32) rst[tid] = 1.0f;
    __syncthreads();
    const int r = lane & 31, h = lane >> 5, kw = K / 8;
    for (int u = bx; u < N / 32; u += G) {
        const int n0 = u * 32;
        const GAS bf16* ap = (const GAS bf16*)A + (size_t)r * K + wave * kw + h * 32;
        const GAS bf16* bp = (const GAS bf16*)Bt + (size_t)(n0 + r) * K + wave * kw + h * 32;
        const GAS bf16* bpt = (const GAS bf16*)Bt + ((size_t)((wave * kw) >> 6) * N + n0 + r) * 64 + h * 32;
        f32x16 acc;
#pragma unroll
        for (int i = 0; i < 16; ++i) acc[i] = 0.f;
        for (int k = 0; k < kw; k += 256) {
            bf16x8 a[16], b[16];
#pragma unroll
            for (int j = 0; j < 16; ++j) { a[j] = *(const GAS bf16x8*)(ap + k + 64 * (j >> 2) + 8 * (j & 3));
                if constexpr (BTILED) b[j] = *(const GAS bf16x8*)(bpt + (size_t)((k >> 6) + (j >> 2)) * N * 64 + 8 * (j & 3)); else b[j] = *(const GAS bf16x8*)(bp + k + 64 * (j >> 2) + 8 * (j & 3)); }
#pragma unroll
            for (int j = 0; j < 16; ++j) acc = __builtin_amdgcn_mfma_f32_32x32x16_bf16(a[j], b[j], acc, 0, 0, 0);
        }
#pragma unroll
        for (int q = 0; q < 16; ++q) red[wave * (32 * 33) + ((q & 3) + 8 * (q >> 2) + 4 * h) * 33 + r] = acc[q];
        __syncthreads();
        const int j = tid & 31, i0 = tid >> 5;
#pragma unroll
        for (int ii = 0; ii < 2; ++ii) { const int i = i0 + 16 * ii; float v = 0.f;
#pragma unroll
            for (int w = 0; w < 8; ++w) v += red[w * (32 * 33) + i * 33 + j];
            const int col = n0 + j; const float rs = rst[i]; float o = 0.f;
            if (e.mode == 0) { e.f0[(size_t)i * N + col] = v * rs; }
            else if (e.mode == 1) { const float z = gelu_t(v * rs); if (col < 2048) e.f0[i * 2048 + col] = z; else e.f1[i * 2048 + col - 2048] = z; }
            else if (e.mode == 2) { o = e.base[(size_t)i * N + col] + v; e.f0[(size_t)i * N + col] = o; if (e.b0) e.b0[(size_t)i * N + col] = (bf16)f2bf(o); }
            else { const float a = fmaxf(v * rs, 0.f); e.b0[(size_t)i * N + col] = (bf16)f2bf(a * a); }
            if (e.mode == 2 && e.ssq_out) { float q = o * o; q += __shfl_xor(q, 1); q += __shfl_xor(q, 2); q += __shfl_xor(q, 4); q += __shfl_xor(q, 8); q += __shfl_xor(q, 16);
                if (j == 0) e.ssq_out[i * 64 + u] = q; } }
        __syncthreads();
    }
}

__device__ __forceinline__ void skinny_gemm_k4(LAS unsigned char* lds, const bf16* A, const bf16* Bt, const SkEpi e, float* part, unsigned* cnt) {
    constexpr int K = 8192, N = 2048;
    const int tid = tid_opaque(), wave = tid >> 6, lane = tid & 63, G = (int)gridDim.x;
    LAS float* red = (LAS float*)lds;
    LAS unsigned* flag = (LAS unsigned*)(lds + 8 * 32 * 33 * 4 + 256);
    const int r = lane & 31, h = lane >> 5;
    for (int w = blockIdx.x; w < 256; w += G) {
        const int u = w >> 2, kq = w & 3, n0 = u * 32, kbase = kq * 2048 + wave * 256;
        const GAS bf16* ap = (const GAS bf16*)A + (size_t)r * K + kbase + h * 32;
        const GAS bf16* bpt = (const GAS bf16*)Bt + ((size_t)(kbase >> 6) * N + n0 + r) * 64 + h * 32;
        f32x16 acc;
#pragma unroll
        for (int q = 0; q < 16; ++q) acc[q] = 0.f;
        { bf16x8 a[16], b[16];
#pragma unroll
          for (int j = 0; j < 16; ++j) { a[j] = *(const GAS bf16x8*)(ap + 64 * (j >> 2) + 8 * (j & 3)); b[j] = *(const GAS bf16x8*)(bpt + (size_t)(j >> 2) * N * 64 + 8 * (j & 3)); }
#pragma unroll
          for (int j = 0; j < 16; ++j) acc = __builtin_amdgcn_mfma_f32_32x32x16_bf16(a[j], b[j], acc, 0, 0, 0); }
#pragma unroll
        for (int q = 0; q < 16; ++q) red[wave * (32 * 33) + ((q & 3) + 8 * (q >> 2) + 4 * h) * 33 + r] = acc[q];
        __syncthreads();
        const int j = tid & 31, i0 = tid >> 5;
#pragma unroll
        for (int ii = 0; ii < 2; ++ii) { const int i = i0 + 16 * ii; float v = 0.f;
#pragma unroll
            for (int ww = 0; ww < 8; ++ww) v += red[ww * (32 * 33) + i * 33 + j];
            part[((size_t)kq * 32 + i) * N + n0 + j] = v; }
        VM_WAIT(); __syncthreads();
        if (tid == 0) { __builtin_amdgcn_fence(__ATOMIC_RELEASE, "agent"); asm volatile("s_waitcnt vmcnt(0)" ::: "memory");
            *flag = __hip_atomic_fetch_add(cnt + u, 1u, __ATOMIC_RELAXED, __HIP_MEMORY_SCOPE_AGENT); }
        __syncthreads();
        if (*flag == 3u) {
            if (tid < 64) { __builtin_amdgcn_fence(__ATOMIC_ACQUIRE, "agent"); asm volatile("s_waitcnt vmcnt(0)" ::: "memory"); }
            __syncthreads();
#pragma unroll
            for (int ii = 0; ii < 2; ++ii) { const int i = i0 + 16 * ii; const float* pp = part + (size_t)i * N + n0 + j;
                const float v = (pp[0] + pp[(size_t)32 * N]) + (pp[(size_t)64 * N] + pp[(size_t)96 * N]);
                const int col = n0 + j; const float o = e.base[(size_t)i * N + col] + v; e.f0[(size_t)i * N + col] = o; if (e.b0) e.b0[(size_t)i * N + col] = (bf16)f2bf(o);
                if (e.ssq_out) { float q = o * o; q += __shfl_xor(q, 1); q += __shfl_xor(q, 2); q += __shfl_xor(q, 4); q += __shfl_xor(q, 8); q += __shfl_xor(q, 16);
                    if (j == 0) e.ssq_out[i * 64 + u] = q; } } }
        __syncthreads();
    }
}

__device__ __forceinline__ void norm_rope2(float& a, float& b, const float* gain, const float* rope_row, int lane, bool do_rope) {
    const float ss = wave_sum(a * a + b * b); const float r = rsqrtf(ss * (1.0f / 128.0f) + EPS);
    a = a * r * gain[2 * lane]; b = b * r * gain[2 * lane + 1];
    if (do_rope) {
        const float pa = __shfl_xor(a, 8), pb = __shfl_xor(b, 8);
        if (lane < 16) { const int i = 2 * (lane & 7); const float c0 = rope_row[i], c1 = rope_row[i + 1], s0 = rope_row[16 + i], s1 = rope_row[16 + i + 1];
            if (lane < 8) { a = a * c0 - pa * s0; b = b * c1 - pb * s1; } else { a = a * c0 + pa * s0; b = b * c1 + pb * s1; } }
    }
}

template <int tiledN = 0>
__device__ __forceinline__ void transpose_item(const float* W, const float* gain, int K, int Nv, int ldw, bf16* WT, int row_off, int nblk, LAS float* scr, int item, int lane) {
    const int kb = item / nblk, nb = item % nblk, k0 = 64 * kb, n0 = 64 * nb; const int nn = n0 + 4 * (lane & 15), kq = lane >> 4;
    f32x4 v[16];
#pragma unroll
    for (int jx = 0; jx < 16; ++jx) { v[jx] = (f32x4){0.f, 0.f, 0.f, 0.f}; if (nn < Nv) v[jx] = __builtin_nontemporal_load((const GAS f32x4*)(W + (size_t)(k0 + 4 * jx + kq) * ldw + nn)); }
#pragma unroll
    for (int jx = 0; jx < 16; ++jx) { const int kk = 4 * jx + kq; const float gg = gain ? gain[k0 + kk] : 1.0f; LAS float* d = scr + kk * 65 + 4 * (lane & 15);
        d[0] = v[jx].x * gg; d[1] = v[jx].y * gg; d[2] = v[jx].z * gg; d[3] = v[jx].w * gg; }
    LDS_WAIT(); asm volatile("" ::: "memory");
#pragma unroll
    for (int jj = 0; jj < 8; ++jj) { const int id = lane + 64 * jj, n = id >> 3, ck = id & 7; const LAS float* s = scr + (8 * ck) * 65 + n;
        u32x4 o; o.x = pk2(s[0 * 65], s[1 * 65]); o.y = pk2(s[2 * 65], s[3 * 65]); o.z = pk2(s[4 * 65], s[5 * 65]); o.w = pk2(s[6 * 65], s[7 * 65]);
        if constexpr (tiledN != 0) *(GAS u32x4*)(WT + ((size_t)kb * tiledN + row_off + n0 + n) * 64 + 8 * ck) = o;
        else *(GAS u32x4*)(WT + (size_t)(row_off + n0 + n) * K + k0 + 8 * ck) = o; }
    LDS_WAIT(); asm volatile("" ::: "memory");
}
__device__ __forceinline__ void row_to_bf16_ssq(const float* xrow, bf16* orow, float* slots, int nslots, int lane) {
    const GAS f32x4* xr = (const GAS f32x4*)xrow + lane; f32x4 v[8]; float s = 0.f;
#pragma unroll
    for (int j = 0; j < 8; ++j) { v[j] = xr[64 * j]; s += (v[j].x * v[j].x + v[j].y * v[j].y) + (v[j].z * v[j].z + v[j].w * v[j].w); }
    s = wave_sum(s);
    GAS unsigned long long* o8 = (GAS unsigned long long*)orow + lane;
#pragma unroll
    for (int j = 0; j < 8; ++j) o8[64 * j] = (unsigned long long)pk2(v[j].x, v[j].y) | ((unsigned long long)pk2(v[j].z, v[j].w) << 32);
    if (lane < nslots) slots[lane] = lane == 0 ? s : 0.f;
}
__device__ __forceinline__ void late_weights(const Params& p, LAS unsigned char* lds, int part, int wg, int nwg) {
    const int tid = tid_opaque(), wave = tid >> 6, lane = tid & 63; LAS float* scr = (LAS float*)(lds + wave * 16640);
    const int n = part == 0 ? 1024 + 4096 : 4096;
    for (int it = wg * 8 + wave; it < n; it += nwg * 8) { int r = it;
#define TR(W_, g_, WT_, K_, Nv_, ldw_, roff_, nblk_) { const int cnt = ((K_) / 64) * (nblk_); if (r < cnt) { transpose_item(W_, g_, K_, Nv_, ldw_, WT_, roff_, nblk_, scr, r, lane); continue; } r -= cnt; }
        if (part == 0) { TR(p.b_w_out(), nullptr, p.W_bout(), 2048, 2048, 2048, 0, 32)
                         TR(p.mlp_w_up() + (size_t)2048 * 8192, p.mlp_norm() + 2048, p.W_up1(), 2048, 8192, 8192, 0, 128) }
        else { if (r < 128 * 32) { transpose_item<2048>(p.mlp_w_down() + (size_t)8192 * 2048, nullptr, 8192, 2048, 2048, p.W_dn1(), 0, 32, scr, r, lane); continue; } }
#undef TR
    }
}
__device__ __forceinline__ void cmp_stream_gemm(const Params& p, LAS unsigned char* lds) {
    const int tid = tid_opaque(), wave = tid >> 6, lane = tid & 63, c4 = lane >> 4, i = lane & 15, G = gridDim.x;
    unsigned sg[8], sl[8];
#pragma unroll
    for (int k = 0; k < 8; ++k) { const int id = tid + NT * k, n = id >> 4, q = id & 15; sg[k] = (unsigned)(n * 2048 + q * 8); sl[k] = (unsigned)(n * 256 + ((q ^ (n & 15)) * 16)); }
    for (int bp = blockIdx.x; bp < 512; bp += G) {
        const int cc = bp >> 8, rem = bp & 255, b = rem >> 3, g = (rem >> 2) & 1, q8 = rem & 3;
        const int n0 = (q8 * 8 + wave) * 16, pos0 = 16 * (n0 + i); const int page = p.ptab()[b * NPAGE + (pos0 >> 7)];
        const float* arow = p.cache() + ((size_t)page * 128 + (pos0 & 127)) * 1024 + cc * 256 + g * 128 + 8 * c4;
        const bf16* wsrc = p.W_cmp() + (size_t)cc * 256 * 2048;
        f32x4 acc[16];
#pragma unroll
        for (int nt = 0; nt < 16; ++nt) acc[nt] = (f32x4){0.f, 0.f, 0.f, 0.f};
        f32x4 ac[8], an[8]; u32x4 wb[8];
#define CS_BAR() do { asm volatile("s_waitcnt lgkmcnt(0)" ::: "memory"); __builtin_amdgcn_s_barrier(); asm volatile("" ::: "memory"); } while (0)
#pragma unroll
        for (int ks = 0; ks < 4; ++ks) { ac[2 * ks] = __builtin_nontemporal_load((const GAS f32x4*)(arow + 32 * ks)); ac[2 * ks + 1] = __builtin_nontemporal_load((const GAS f32x4*)(arow + 32 * ks + 4)); }
#pragma unroll
        for (int k = 0; k < 8; ++k) wb[k] = *(const GAS u32x4*)(wsrc + sg[k]);
#pragma unroll
        for (int k = 0; k < 8; ++k) *(LAS u32x4*)(lds + sl[k]) = wb[k];
        CS_BAR();
        for (int r = 0; r < 16; ++r) { const int buf = (r & 1) * 65536;
            if (r + 1 < 16) {
#pragma unroll
                for (int k = 0; k < 8; ++k) wb[k] = *(const GAS u32x4*)(wsrc + (r + 1) * 128 + sg[k]);
#pragma unroll
                for (int ks = 0; ks < 4; ++ks) { an[2 * ks] = __builtin_nontemporal_load((const GAS f32x4*)(arow + (size_t)(r + 1) * 1024 + 32 * ks)); an[2 * ks + 1] = __builtin_nontemporal_load((const GAS f32x4*)(arow + (size_t)(r + 1) * 1024 + 32 * ks + 4)); } }
#pragma unroll
            for (int ks = 0; ks < 4; ++ks) { u32x4 w; w.x = pk2(ac[2 * ks].x, ac[2 * ks].y); w.y = pk2(ac[2 * ks].z, ac[2 * ks].w); w.z = pk2(ac[2 * ks + 1].x, ac[2 * ks + 1].y); w.w = pk2(ac[2 * ks + 1].z, ac[2 * ks + 1].w);
                const bf16x8 af = __builtin_bit_cast(bf16x8, w);
#pragma unroll
                for (int nt = 0; nt < 16; ++nt) acc[nt] = __builtin_amdgcn_mfma_f32_16x16x32_bf16(*(const LAS bf16x8*)(lds + buf + (16 * nt + i) * 256 + (((4 * ks + c4) ^ i) * 16)), af, acc[nt], 0, 0, 0);
                asm volatile("" ::: "memory"); }
            if (r + 1 < 16) {
#pragma unroll
                for (int k = 0; k < 8; ++k) *(LAS u32x4*)(lds + (65536 - buf) + sl[k]) = wb[k];
#pragma unroll
                for (int k = 0; k < 8; ++k) ac[k] = an[k]; }
            CS_BAR(); }
#undef CS_BAR
        float* frow = p.FCMPS() + ((size_t)cc * 32768 + (size_t)(b * 2 + g) * 512 + n0 + i) * 256 + 4 * c4;
#pragma unroll
        for (int nt = 0; nt < 16; ++nt) *(GAS f32x4*)(frow + 16 * nt) = acc[nt];
    }
}
__device__ __forceinline__ void phase0(const Params& p, LAS unsigned char* lds) {
    const int tid = tid_opaque(), wave = tid >> 6, lane = tid & 63; const int gw = blockIdx.x * 8 + wave, NGW = gridDim.x * 8;
    LAS float* scr = (LAS float*)(lds + wave * 16640);
    constexpr int NITEMS = 2048 + 1024 + 2 * 4096 + 768 + 1152 + 4 * 64;
    for (int it = gw; it < NITEMS; it += NGW) {
        int r = it;
#define TR(W_, g_, WT_, K_, Nv_, ldw_, roff_, nblk_) { const int cnt = ((K_) / 64) * (nblk_); if (r < cnt) { transpose_item(W_, g_, K_, Nv_, ldw_, WT_, roff_, nblk_, scr, r, lane); continue; } r -= cnt; }
        TR(p.a_w_in(), p.a_norm(), p.W_ain(), 2048, 4096, 4096, 0, 64)
        TR(p.a_w_out(), nullptr, p.W_aout(), 2048, 2048, 2048, 0, 32)
        TR(p.mlp_w_up(), p.mlp_norm(), p.W_up0(), 2048, 8192, 8192, 0, 128)
        { const int cnt = 128 * 32; if (r < cnt) { transpose_item<2048>(p.mlp_w_down(), nullptr, 8192, 2048, 2048, p.W_dn0(), 0, 32, scr, r, lane); continue; } r -= cnt; }
        TR(p.w_kv(), p.kv_norm(), p.W_kvq(), 2048, 1536, 1536, 0, 24)
        TR(p.b_w_in(), p.b_norm(), p.W_kvq(), 2048, 2096, 2096, 1536, 36)
        TR(p.cmp_w1(), nullptr, p.W_cmp(), 2048, 128, 128, 0, 2)
        TR(p.cmp_w1() + (size_t)16 * 128 * 128, nullptr, p.W_cmp(), 2048, 128, 128, 128, 2)
        TR(p.cmp_w1() + (size_t)32 * 128 * 128, nullptr, p.W_cmp(), 2048, 128, 128, 256, 2)
        TR(p.cmp_w1() + (size_t)48 * 128 * 128, nullptr, p.W_cmp(), 2048, 128, 128, 384, 2)
#undef TR
    }
    for (int m = gw; m < MP; m += NGW) row_to_bf16_ssq(p.x_p() + (size_t)m * D, p.XB() + (size_t)m * D, p.x_ssq() + (size_t)m * 32, 32, lane);
    for (int m = gw; m < MS; m += NGW) row_to_bf16_ssq(p.x_s() + (size_t)m * D, p.XSB() + (size_t)m * D, p.xs_ssq() + (size_t)m * 64, 64, lane);
    for (int pos = gw; pos < 8208; pos += NGW) if (lane < 16) {
        const float inv = (float)pow(500000.0, -(double)(2 * lane) / 32.0); const float ang = (float)pos * inv;
        p.ROPE()[pos * 32 + lane] = (float)cos((double)ang); p.ROPE()[pos * 32 + 16 + lane] = (float)sin((double)ang); }
    for (int it = gw; it < 64; it += NGW) { const float* pe = p.cmp_pe() + (size_t)it * 128; const float* w = p.cmp_w1() + (size_t)it * 128 * 128; float a0 = 0.f, a1 = 0.f;
        for (int d = 0; d < 128; ++d) { const float x = pe[d]; a0 += x * w[d * 128 + lane]; a1 += x * w[d * 128 + 64 + lane]; }
        p.CBIAS()[it * 128 + lane] = a0; p.CBIAS()[it * 128 + 64 + lane] = a1; }
    for (int it = gw; it < MS * 128; it += NGW) { const int b = it >> 7, i0 = (it & 127) * 4; f32x4 v[8];
#pragma unroll
        for (int q = 0; q < 4; ++q) { const int i = i0 + q < 511 ? i0 + q : 510; const GAS f32x4* src = (const GAS f32x4*)(p.state() + ((size_t)b * 512 + i + 1) * 512) + lane; v[2 * q] = src[0]; v[2 * q + 1] = src[64]; }
#pragma unroll
        for (int q = 0; q < 4; ++q) if (i0 + q < 511) { GAS f32x4* dst = (GAS f32x4*)(p.out + O_WINS + ((size_t)b * 512 + i0 + q) * 512) + lane; dst[0] = v[2 * q]; dst[64] = v[2 * q + 1]; } }
}

__device__ __forceinline__ void gating_block(const Params& p, LAS unsigned char* lds) {
    const int tid = tid_opaque(), wave = tid >> 6, lane = tid & 63, c = lane >> 4, j = lane & 15, G = gridDim.x;
    LAS float* rvs = (LAS float*)(lds + 34816);
    const int tt = 16 * wave + j, nkk = (wave >> 1) + 1;
    int gcur = -1; bf16x8 wf[4]; float bias = 0.f; f32x2 gn = {0.f, 0.f};
    float rsv = 0.f; unsigned vw0[8], vw1[8]; u32x2 uu[8];
#define GT_LOAD(bi_) do { const int g_ = (bi_) & 15, m0_ = ((bi_) >> 4) * 128; \
        if (tid < 128) { const GAS f32x4* pp_ = (const GAS f32x4*)(p.v_ssq() + (size_t)(m0_ + tid) * 32); float s_ = 0.f; \
            _Pragma("unroll") for (int k = 0; k < 8; ++k) { const f32x4 x_ = pp_[k]; s_ += (x_.x + x_.y) + (x_.z + x_.w); } rsv = s_; } \
        _Pragma("unroll") for (int k = 0; k < 8; ++k) { const int idx_ = tid + NT * k, s2_ = (idx_ >> 6) * 2, d2_ = (idx_ & 63) * 2; \
            vw0[k] = *(const GAS unsigned*)(p.V() + (size_t)(m0_ + s2_) * 2048 + g_ * 128 + d2_); vw1[k] = *(const GAS unsigned*)(p.V() + (size_t)(m0_ + s2_ + 1) * 2048 + g_ * 128 + d2_); } \
        _Pragma("unroll") for (int dt = 0; dt < 8; ++dt) uu[dt] = *(const GAS u32x2*)(p.U() + (size_t)(m0_ + tt) * 2048 + g_ * 128 + 4 * c + 16 * dt); } while (0)
    int bi = blockIdx.x;
    if (bi < 1024) GT_LOAD(bi);
    for (; bi < 1024; bi += G) { const int g = bi & 15, m0 = (bi >> 4) * 128;
        if (g != gcur) { gcur = g;
#pragma unroll
            for (int kk = 0; kk < 4; ++kk) { f32x4 x0 = {0.f, 0.f, 0.f, 0.f}, x1 = {0.f, 0.f, 0.f, 0.f}; const int s0 = 32 * kk + 8 * c;
                if (kk < nkk) { const GAS f32x4* wp = (const GAS f32x4*)(p.a_w_s() + (size_t)(g * 128 + tt) * 128 + s0); x0 = wp[0]; x1 = wp[1]; }
                x0.x = s0 + 0 <= tt ? x0.x : 0.f; x0.y = s0 + 1 <= tt ? x0.y : 0.f; x0.z = s0 + 2 <= tt ? x0.z : 0.f; x0.w = s0 + 3 <= tt ? x0.w : 0.f;
                x1.x = s0 + 4 <= tt ? x1.x : 0.f; x1.y = s0 + 5 <= tt ? x1.y : 0.f; x1.z = s0 + 6 <= tt ? x1.z : 0.f; x1.w = s0 + 7 <= tt ? x1.w : 0.f;
                u32x4 w; w.x = pk2(x0.x, x0.y); w.y = pk2(x0.z, x0.w); w.z = pk2(x1.x, x1.y); w.w = pk2(x1.z, x1.w); wf[kk] = __builtin_bit_cast(bf16x8, w); }
            bias = p.a_b_s()[g * 128 + tt]; gn = *(const GAS f32x2*)(p.a_v_norm() + g * 128 + (tid & 63) * 2); }
        if (tid < 128) rvs[tid] = rsqrtf(rsv * (1.0f / 2048.0f) + EPS);
        __syncthreads();
#pragma unroll
        for (int k = 0; k < 8; ++k) { const int idx = tid + NT * k, s2 = (idx >> 6) * 2, d2 = (idx & 63) * 2; const unsigned w0 = vw0[k], w1 = vw1[k];
            const float r0 = rvs[s2], r1 = rvs[s2 + 1];
            *(LAS unsigned*)(lds + d2 * 272 + s2 * 2) = pk2(bf2f(w0 & 0xffffu) * r0 * gn.x, bf2f(w1 & 0xffffu) * r1 * gn.x);
            *(LAS unsigned*)(lds + (d2 + 1) * 272 + s2 * 2) = pk2(bf2f(w0 >> 16) * r0 * gn.y, bf2f(w1 >> 16) * r1 * gn.y); }
        u32x2 uc[8];
#pragma unroll
        for (int dt = 0; dt < 8; ++dt) uc[dt] = uu[dt];
        __syncthreads();
        if (bi + G < 1024) GT_LOAD(bi + G);
        f32x4 acc[8];
#pragma unroll
        for (int dt = 0; dt < 8; ++dt) acc[dt] = (f32x4){0.f, 0.f, 0.f, 0.f};
#pragma unroll
        for (int kk = 0; kk < 4; ++kk) if (kk < nkk) {
#pragma unroll
            for (int dt = 0; dt < 8; ++dt) acc[dt] = __builtin_amdgcn_mfma_f32_16x16x32_bf16(*(const LAS bf16x8*)(lds + (16 * dt + j) * 272 + (4 * kk + c) * 16), wf[kk], acc[dt], 0, 0, 0); }
        const size_t o0 = (size_t)(m0 + tt) * 2048 + g * 128 + 4 * c;
#pragma unroll
        for (int dt = 0; dt < 8; ++dt) { const u32x2 ux = uc[dt]; u32x2 w;
            w.x = pk2(bf2f(ux.x & 0xffffu) * (acc[dt][0] + bias), bf2f(ux.x >> 16) * (acc[dt][1] + bias)); w.y = pk2(bf2f(ux.y & 0xffffu) * (acc[dt][2] + bias), bf2f(ux.y >> 16) * (acc[dt][3] + bias));
            *(GAS u32x2*)(p.GT() + o0 + 16 * dt) = w; }
        __syncthreads();
    }
#undef GT_LOAD
}
__device__ __forceinline__ void sample_gating_row(const Params& p, int i, int lane) {
    const GAS f32x4* vr = (const GAS f32x4*)(p.VS() + (size_t)i * 2048) + lane; f32x4 v[8]; float s = 0.f;
#pragma unroll
    for (int j = 0; j < 8; ++j) { v[j] = vr[64 * j]; s += (v[j].x * v[j].x + v[j].y * v[j].y) + (v[j].z * v[j].z + v[j].w * v[j].w); }
    const float rv = rsqrtf(wave_sum(s) * (1.0f / 2048.0f) + EPS);
#pragma unroll
    for (int j = 0; j < 8; ++j) { const int col = 4 * (lane + 64 * j), g = col >> 7; const float w00 = p.a_w_s()[(size_t)g * 128 * 128], b0 = p.a_b_s()[g * 128];
        const f32x4 gn = *(const GAS f32x4*)(p.a_v_norm() + col); const f32x4 vn = v[j] * rv * gn; *(GAS f32x4*)(p.out + O_VAS + (size_t)i * 2048 + col) = vn;
        const f32x4 uu = *(const GAS f32x4*)(p.US() + (size_t)i * 2048 + col); const f32x4 o = uu * (vn * w00 + b0);
        u32x2 w; w.x = pk2(o.x, o.y); w.y = pk2(o.z, o.w); *(GAS u32x2*)(p.GTS() + (size_t)i * 2048 + col) = w; }
}

constexpr int CW_IMG = 34816, CW_BIAS = 4 * CW_IMG + 64;
__device__ __forceinline__ void cmp_w2_to_lds(const Params& p, LAS unsigned char* lds) {
    const int tid = tid_opaque();
    for (int k0 = 0; k0 < 32; k0 += 8) { float w0[8], w1[8];
#pragma unroll
        for (int k = 0; k < 8; ++k) { const int idx = tid + NT * (k0 + k), cm = idx >> 13, rem = idx & 8191, e2 = rem & 127, e = (rem >> 7) * 2;
            w0[k] = p.cmp_w2()[(size_t)cm * 16384 + e * 128 + e2]; w1[k] = p.cmp_w2()[(size_t)cm * 16384 + (e + 1) * 128 + e2]; }
#pragma unroll
        for (int k = 0; k < 8; ++k) { const int idx = tid + NT * (k0 + k), cm = idx >> 13, rem = idx & 8191, e2 = rem & 127, e = (rem >> 7) * 2;
            const unsigned h0 = f2bf(w0[k]), h1 = f2bf(w1[k]); const unsigned l0 = f2bf(w0[k] - bf2f(h0)), l1 = f2bf(w1[k] - bf2f(h1));
            *(LAS unsigned*)(lds + (2 * cm) * CW_IMG + e2 * 272 + e * 2) = h0 | (h1 << 16); *(LAS unsigned*)(lds + (2 * cm + 1) * CW_IMG + e2 * 272 + e * 2) = l0 | (l1 << 16); } }
    if (tid < 256) ((LAS float*)(lds + CW_BIAS))[tid] = p.CBIASF()[tid];
}
template <int NS> __device__ __forceinline__ void cmp_finish16(const float* Fk, const float* Fv, size_t sstride, int i0, int nvalid, const LAS unsigned char* lds, const float* knorm0, const float* rope, int lane, f32x4 (&kc)[8], f32x4 (&vc)[8]) {
    const int c = lane >> 4, j = lane & 15; const int row = i0 + j < nvalid ? i0 + j : nvalid - 1;
    const LAS float* bias = (const LAS float*)(lds + CW_BIAS);
    bf16x8 hkh[4], hkl[4], hvh[4], hvl[4];
#pragma unroll
    for (int kk = 0; kk < 4; ++kk) { const int e0 = 32 * kk + 8 * c; float xk[8], xv[8];
#pragma unroll
        for (int q = 0; q < 8; ++q) { xk[q] = bias[e0 + q]; xv[q] = bias[128 + e0 + q]; }
#pragma unroll 1
        for (int ks = 0; ks < NS; ++ks) { const float* fk = Fk + ks * sstride + (size_t)(row - i0) * 256 + e0; const float* fv = Fv + ks * sstride + (size_t)(row - i0) * 256 + e0;
            const f32x4 a0 = *(const GAS f32x4*)fk, a1 = *(const GAS f32x4*)(fk + 4), b0 = *(const GAS f32x4*)(fk + 256 + 128), b1 = *(const GAS f32x4*)(fk + 256 + 128 + 4);
            const f32x4 c0 = *(const GAS f32x4*)fv, c1 = *(const GAS f32x4*)(fv + 4), d0 = *(const GAS f32x4*)(fv + 256 + 128), d1 = *(const GAS f32x4*)(fv + 256 + 128 + 4);
            xk[0] += a0.x + b0.x; xk[1] += a0.y + b0.y; xk[2] += a0.z + b0.z; xk[3] += a0.w + b0.w; xk[4] += a1.x + b1.x; xk[5] += a1.y + b1.y; xk[6] += a1.z + b1.z; xk[7] += a1.w + b1.w;
            xv[0] += c0.x + d0.x; xv[1] += c0.y + d0.y; xv[2] += c0.z + d0.z; xv[3] += c0.w + d0.w; xv[4] += c1.x + d1.x; xv[5] += c1.y + d1.y; xv[6] += c1.z + d1.z; xv[7] += c1.w + d1.w; }
        unsigned kh[8], kl[8], vh[8], vl[8];
#pragma unroll
        for (int q = 0; q < 8; ++q) { const float hk = silu_f(xk[q]), hv = silu_f(xv[q]); kh[q] = f2bf(hk); kl[q] = f2bf(hk - bf2f(kh[q])); vh[q] = f2bf(hv); vl[q] = f2bf(hv - bf2f(vh[q])); }
        u32x4 w;
        w.x = kh[0] | (kh[1] << 16); w.y = kh[2] | (kh[3] << 16); w.z = kh[4] | (kh[5] << 16); w.w = kh[6] | (kh[7] << 16); hkh[kk] = __builtin_bit_cast(bf16x8, w);
        w.x = kl[0] | (kl[1] << 16); w.y = kl[2] | (kl[3] << 16); w.z = kl[4] | (kl[5] << 16); w.w = kl[6] | (kl[7] << 16); hkl[kk] = __builtin_bit_cast(bf16x8, w);
        w.x = vh[0] | (vh[1] << 16); w.y = vh[2] | (vh[3] << 16); w.z = vh[4] | (vh[5] << 16); w.w = vh[6] | (vh[7] << 16); hvh[kk] = __builtin_bit_cast(bf16x8, w);
        w.x = vl[0] | (vl[1] << 16); w.y = vl[2] | (vl[3] << 16); w.z = vl[4] | (vl[5] << 16); w.w = vl[6] | (vl[7] << 16); hvl[kk] = __builtin_bit_cast(bf16x8, w); if (NS > 1) asm volatile("" ::: "memory"); }
#pragma unroll
    for (int dt = 0; dt < 8; ++dt) { kc[dt] = (f32x4){0.f, 0.f, 0.f, 0.f}; vc[dt] = (f32x4){0.f, 0.f, 0.f, 0.f}; }
#pragma unroll
    for (int kk = 0; kk < 4; ++kk)
#pragma unroll
        for (int dt = 0; dt < 8; ++dt) { const LAS unsigned char* wp = lds + (16 * dt + j) * 272 + (4 * kk + c) * 16;
            const bf16x8 wkh = *(const LAS bf16x8*)wp, wkl = *(const LAS bf16x8*)(wp + CW_IMG), wvh = *(const LAS bf16x8*)(wp + 2 * CW_IMG), wvl = *(const LAS bf16x8*)(wp + 3 * CW_IMG);
            kc[dt] = __builtin_amdgcn_mfma_f32_16x16x32_bf16(wkl, hkh[kk], kc[dt], 0, 0, 0); kc[dt] = __builtin_amdgcn_mfma_f32_16x16x32_bf16(wkh, hkl[kk], kc[dt], 0, 0, 0); kc[dt] = __builtin_amdgcn_mfma_f32_16x16x32_bf16(wkh, hkh[kk], kc[dt], 0, 0, 0);
            vc[dt] = __builtin_amdgcn_mfma_f32_16x16x32_bf16(wvl, hvh[kk], vc[dt], 0, 0, 0); vc[dt] = __builtin_amdgcn_mfma_f32_16x16x32_bf16(wvh, hvl[kk], vc[dt], 0, 0, 0); vc[dt] = __builtin_amdgcn_mfma_f32_16x16x32_bf16(wvh, hvh[kk], vc[dt], 0, 0, 0);
            if (dt & 1) asm volatile("" ::: "memory"); }
    float ss = 0.f;
#pragma unroll
    for (int dt = 0; dt < 8; ++dt) ss += (kc[dt][0] * kc[dt][0] + kc[dt][1] * kc[dt][1]) + (kc[dt][2] * kc[dt][2] + kc[dt][3] * kc[dt][3]);
    ss += __shfl_xor(ss, 16); ss += __shfl_xor(ss, 32); const float rn = rsqrtf(ss * (1.0f / 128.0f) + EPS);
#pragma unroll
    for (int dt = 0; dt < 8; ++dt) { const f32x4 gn = *(const GAS f32x4*)(knorm0 + 16 * dt + 4 * c); kc[dt] = kc[dt] * rn * gn; }
    const float* rr = rope + (size_t)(16 * (i0 + j) + 31) * 32; const f32x4 cs = *(const GAS f32x4*)(rr + 4 * c), sn = *(const GAS f32x4*)(rr + 16 + 4 * c);
    const f32x4 x1 = kc[0], x2 = kc[1]; kc[0] = x1 * cs - x2 * sn; kc[1] = x2 * cs + x1 * sn;
}

constexpr float QSC = 0.08838834764831845f * 1.4426950408889634f;
struct FinRow { f32x2 ks[2], wv[4]; unsigned qw[16]; };
__device__ __forceinline__ void finish_row_load(const Params& p, int m, int lane, FinRow& r) {
    const float* kvp = p.out + O_KVP + (size_t)m * 1024; const float* wf = p.WINF() + (size_t)m * 512;
#pragma unroll
    for (int x = 0; x < 2; ++x) r.ks[x] = *(const GAS f32x2*)(kvp + (4 + x) * 128 + 2 * lane);
#pragma unroll
    for (int x = 0; x < 4; ++x) r.wv[x] = *(const GAS f32x2*)(wf + x * 128 + 2 * lane);
#pragma unroll
    for (int h = 0; h < 16; ++h) r.qw[h] = *(const GAS unsigned*)(p.QRAW() + (size_t)m * 2048 + h * 128 + 2 * lane);
}
__device__ __forceinline__ void finish_row_prompt(const Params& p, int m, int lane, const FinRow& r) {
    const int b = m >> 12, t = m & 4095; const float* rr = p.ROPE() + (size_t)t * 32;
    float* kvp = p.out + O_KVP + (size_t)m * 1024; float* wf = p.WINF() + (size_t)m * 512;
#pragma unroll
    for (int g = 0; g < 2; ++g) {
        { float a = r.ks[g].x, c = r.ks[g].y; norm_rope2(a, c, p.k_norm() + 128, rr, lane, true);
          *(GAS f32x2*)(kvp + 512 + g * 128 + 2 * lane) = (f32x2){a, c};
          *(GAS unsigned*)(p.KSLC() + ((size_t)(b * 2 + g) * 4096 + t) * 128 + 2 * lane) = pk2(a, c); }
        { float a = r.wv[g].x, c = r.wv[g].y; norm_rope2(a, c, p.k_norm() + 256, rr, lane, true);
          *(GAS f32x2*)(wf + g * 128 + 2 * lane) = (f32x2){a, c};
          *(GAS unsigned*)(p.KWIN() + ((size_t)(b * 2 + g) * 4096 + t) * 128 + 2 * lane) = pk2(a, c);
          if (t >= 3584) { float* wo = p.out + O_WINP + ((size_t)b * 512 + (t - 3584)) * 512; *(GAS f32x2*)(wo + g * 128 + 2 * lane) = (f32x2){a, c}; *(GAS f32x2*)(wo + 256 + g * 128 + 2 * lane) = r.wv[2 + g]; } }
    }
#pragma unroll
    for (int h = 0; h < 16; ++h) { float a = bf2f(r.qw[h] & 0xffffu), c = __builtin_bit_cast(float, r.qw[h] & 0xffff0000u); norm_rope2(a, c, p.b_q_norm(), rr, lane, true); *(GAS unsigned*)(p.QN() + (size_t)m * 2048 + h * 128 + 2 * lane) = pk2(a * QSC, c * QSC); }
}
__device__ __forceinline__ void vt_item(const Params& p, int item, LAS unsigned char* lds) {
    const int tile = item & 63, g = (item >> 6) & 1, b = (item >> 7) & 1, which = item >> 8, tid = tid_opaque();
    LAS float* tl = (LAS float*)lds;
    const int m0 = b * 4096 + tile * 64;
    const float* src = which == 0 ? p.out + O_KVP + (size_t)m0 * 1024 + 768 + g * 128 : p.WINF() + (size_t)m0 * 512 + 256 + g * 128; const int ld = which == 0 ? 1024 : 512;
    f32x4 v[4];
#pragma unroll
    for (int k = 0; k < 4; ++k) { const int idx = tid + NT * k, tt = idx >> 5, d4 = (idx & 31) * 4; v[k] = *(const GAS f32x4*)(src + (size_t)tt * ld + d4); }
#pragma unroll
    for (int k = 0; k < 4; ++k) { const int idx = tid + NT * k, tt = idx >> 5, d4 = (idx & 31) * 4; LAS float* d = tl + tt * 129 + d4; d[0] = v[k].x; d[1] = v[k].y; d[2] = v[k].z; d[3] = v[k].w; }
    __syncthreads();
    bf16* dst = (which == 0 ? p.VSLCT() : p.VWINT()) + (size_t)((b * 2 + g) * 64 + tile) * 8192;
#pragma unroll
    for (int k = 0; k < 2; ++k) { const int idx = tid + NT * k, d = idx >> 3, ck = idx & 7; const LAS float* s = tl + (8 * ck) * 129 + d;
        u32x4 o; o.x = pk2(s[0], s[129]); o.y = pk2(s[2 * 129], s[3 * 129]); o.z = pk2(s[4 * 129], s[5 * 129]); o.w = pk2(s[6 * 129], s[7 * 129]);
        *(GAS u32x4*)(dst + d * 64 + 8 * ck) = o; }
    __syncthreads();
}
__device__ __forceinline__ void finish_row_sample(const Params& p, int i, int lane) {
    const float* src = p.KVQS() + (size_t)i * NKVQ; const float* rr = p.ROPE() + (size_t)8192 * 32;
    float* kvs = p.out + O_KVS + (size_t)i * 1024; float* wrow = p.out + O_WINS + ((size_t)i * 512 + 511) * 512;
    for (int ch = 0; ch < 28; ++ch) { f32x2 v = *(const GAS f32x2*)(src + ch * 128 + 2 * lane); float a = v.x, c = v.y;
        if (ch < 12) { const int s = ch >> 1, g = ch & 1;
            if (s == 2) norm_rope2(a, c, p.k_norm() + 128, rr, lane, true);
            if (s == 4) norm_rope2(a, c, p.k_norm() + 256, rr, lane, true);
            if (s < 4) *(GAS f32x2*)(kvs + s * 256 + g * 128 + 2 * lane) = (f32x2){a, c}; else *(GAS f32x2*)(wrow + (s - 4) * 256 + g * 128 + 2 * lane) = (f32x2){a, c}; }
        else { const int h = ch - 12; norm_rope2(a, c, p.b_q_norm(), rr, lane, true); *(GAS f32x2*)(p.QS() + (size_t)i * 2048 + h * 128 + 2 * lane) = (f32x2){a, c}; } }
    if (lane < 48) p.GS()[i * 48 + lane] = sigmoid_f(src[3584 + lane]);
}

#define MFMA16(a, b, c) __builtin_amdgcn_mfma_f32_16x16x32_bf16(a, b, c, 0, 0, 0)
__device__ __forceinline__ bf16x8 pack_p(const f32x4 a, const f32x4 b) { u32x4 w; w.x = pk2(a[0], a[1]); w.y = pk2(a[2], a[3]); w.z = pk2(b[0], b[1]); w.w = pk2(b[2], b[3]); return __builtin_bit_cast(bf16x8, w); }
constexpr int AT_KB = 0, AT_VB = 32768, AT_PS = 65536, AT_UM = 65536 + 16384;
#define AT_ISSUE(kt, vt, doV) do { stK0 = *(const GAS u32x4*)((kt) + gK); stK1 = *(const GAS u32x4*)((kt) + gK + 32 * 128); \
    if (doV) { stV0 = *(const GAS u32x4*)((vt) + gV); stV1 = *(const GAS u32x4*)((vt) + gV + 4096); } } while (0)
#define AT_COMMIT(buf, doV) do { *(LAS u32x4*)(lds + AT_KB + (buf) * 16384 + lK) = stK0; *(LAS u32x4*)(lds + AT_KB + (buf) * 16384 + lK + 8192) = stK1; \
    if (doV) { *(LAS u32x4*)(lds + AT_VB + (buf) * 16384 + lV) = stV0; *(LAS u32x4*)(lds + AT_VB + (buf) * 16384 + lV + 8192) = stV1; } } while (0)
constexpr float AT_SHIFT = 16.0f;
#define AT_SCORES(buf, blk0, FULL, rowok, tlo, thi) \
    f32x4 s4[2][2]; \
    _Pragma("unroll") for (int pp = 0; pp < 2; ++pp) { f32x4 a0_ = {0.f, 0.f, 0.f, 0.f}, a1_ = {0.f, 0.f, 0.f, 0.f};                   \
        _Pragma("unroll") for (int kk = 0; kk < 4; ++kk) { a0_ = MFMA16(*(const LAS bf16x8*)(lds + AT_KB + (buf) * 16384 + (2 * pp) * 4096 + kofs[kk]), qf[kk], a0_); \
            a1_ = MFMA16(*(const LAS bf16x8*)(lds + AT_KB + (buf) * 16384 + (2 * pp + 1) * 4096 + kofs[kk]), qf[kk], a1_); } \
        s4[pp][0] = a0_; s4[pp][1] = a1_; \
        if (pp == 0) asm volatile("" ::: "memory"); } \
    _Pragma("unroll") for (int pp = 0; pp < 2; ++pp) _Pragma("unroll") for (int hb = 0; hb < 2; ++hb) _Pragma("unroll") for (int e = 0; e < 4; ++e) { \
        if ((FULL) == 0) { const int kpos_ = (blk0) + 32 * pp + 8 * c + 4 * hb + e; const bool ok_ = (rowok) && kpos_ <= (thi) && kpos_ >= (tlo); s4[pp][hb][e] = ok_ ? s4[pp][hb][e] : -1e30f; } \
        if ((FULL) == 1) s4[pp][hb][e] = (rowok) ? s4[pp][hb][e] : -1e30f; }
#define AT_PV(buf) \
    _Pragma("unroll") for (int pp = 0; pp < 2; ++pp) { const bf16x8 pf_ = pack_p(s4[pp][0], s4[pp][1]); \
        _Pragma("unroll") for (int dt = 0; dt < 8; ++dt) oa[dt] = MFMA16(*(const LAS bf16x8*)(lds + AT_VB + (buf) * 16384 + dt * 2048 + vofs[pp]), pf_, oa[dt]); \
        if (pp == 0) asm volatile("" ::: "memory"); }
#define AT_STEP_ONLINE(buf, blk0, FULL, rowok, tlo, thi) do { AT_SCORES(buf, blk0, FULL, rowok, tlo, thi) \
    float ps_ = 0.f; \
    _Pragma("unroll") for (int pp = 0; pp < 2; ++pp) _Pragma("unroll") for (int hb = 0; hb < 2; ++hb) _Pragma("unroll") for (int e = 0; e < 4; ++e) { \
        const float pv_ = __builtin_amdgcn_exp2f(s4[pp][hb][e] - AT_SHIFT); s4[pp][hb][e] = pv_; ps_ += pv_; } \
    l_run += ps_; \
    AT_PV(buf) } while (0)
#define AT_STEP_STATS(buf, blk0, thi) do { AT_SCORES(buf, blk0, 0, true, 0, thi) \
    float ps_ = 0.f; \
    _Pragma("unroll") for (int pp = 0; pp < 2; ++pp) _Pragma("unroll") for (int hb = 0; hb < 2; ++hb) _Pragma("unroll") for (int e = 0; e < 4; ++e) ps_ += __builtin_amdgcn_exp2f(s4[pp][hb][e] - AT_SHIFT); \
    l_run += ps_; } while (0)
#define AT_STEP_FINAL(buf, blk0, thi) do { AT_SCORES(buf, blk0, 0, true, 0, thi) \
    _Pragma("unroll") for (int pp = 0; pp < 2; ++pp) _Pragma("unroll") for (int hb = 0; hb < 2; ++hb) { _Pragma("unroll") for (int e = 0; e < 4; ++e) { \
        s4[pp][hb][e] = __builtin_amdgcn_exp2f(s4[pp][hb][e] - AT_SHIFT) * il_c; } \
        f32x4 hs_ = s4[pp][hb]; \
        _Pragma("unroll") for (int e = 0; e < 4; ++e) { float x_ = hs_[e]; x_ += __shfl_xor(x_, 1); x_ += __shfl_xor(x_, 2); x_ += __shfl_xor(x_, 4); hs_[e] = x_; } \
        if (r == 0) *(LAS f32x4*)(ps + qi * 256 + (blk0) + 32 * pp + 8 * c + 4 * hb) = hs_; } \
    AT_PV(buf) } while (0)

__device__ __forceinline__ void attn_prompt_unit(const Params& p, int b, int g, int t0w, LAS unsigned char* lds, int tid) {
    const int wave = tid >> 6, lane = tid & 63;
    const int c = lane >> 4, j = lane & 15, qi = j >> 3, r = j & 7, h = g * 8 + r;
    const int t0 = t0w + 2 * wave, t = t0 + qi, m = b * 4096 + t, bg = b * 2 + g;
    LAS float* ps = (LAS float*)(lds + AT_PS + wave * 2048);
    unsigned kofs[4], vofs[2];
#pragma unroll
    for (int kk = 0; kk < 4; ++kk) kofs[kk] = (unsigned)(j * 256 + (((4 * kk + c) ^ j) * 16));
#pragma unroll
    for (int pp = 0; pp < 2; ++pp) vofs[pp] = (unsigned)(j * 128 + (((4 * pp + c) ^ ((j >> 1) & 7)) * 16));
    unsigned gK, lK, gV, lV;
    { const int rho = tid >> 4, q = tid & 15, i = rho & 15, t4 = rho >> 4; const int key = 32 * (t4 >> 1) + 4 * (t4 & 1) + 8 * (i >> 2) + (i & 3);
      gK = (unsigned)(key * 128 + q * 8); lK = (unsigned)(rho * 256 + ((q ^ i) * 16));
      const int d = tid >> 3, qv = tid & 7; gV = (unsigned)(d * 64 + qv * 8); lV = (unsigned)(d * 128 + ((qv ^ ((d >> 1) & 7)) * 16)); }
    u32x4 stK0, stK1, stV0, stV1;
    bf16x8 qf[4];
    { const GAS bf16* qp = (const GAS bf16*)p.QN() + (size_t)m * 2048 + h * 128 + 8 * c;
#pragma unroll
      for (int kk = 0; kk < 4; ++kk) qf[kk] = *(const GAS bf16x8*)(qp + 32 * kk); }
    f32x4 res[8]; f32x4 oa[8]; float l_run;
    int cb = 0;
    const GAS bf16* kbW = (const GAS bf16*)p.KWIN() + (size_t)(bg * 4096) * 128;
    const GAS bf16* vtbW = (const GAS bf16*)p.VWINT() + (size_t)(bg * 64) * 8192;
    const int w_lo = (t0w >= 511 ? t0w - 511 : 0) >> 6, w_hi = (t0w + 15) >> 6, w_nb = w_hi - w_lo + 1;
    {
        const GAS bf16* kc = (const GAS bf16*)p.KC() + (size_t)(bg * 256) * 128;
        const GAS bf16* vct = (const GAS bf16*)p.VCT() + (size_t)(bg * 4) * 8192;
        const int nvis = (t >= 31) ? ((t - 31) >> 4) + 1 : 0;
        const int tl = t0w + 15; const int nvis_wg = (tl >= 31) ? ((tl - 31) >> 4) + 1 : 0; const int nb = (nvis_wg + 63) >> 6;
        l_run = 0.f;
        if (nb > 0) { AT_ISSUE(kc, vct, false); AT_COMMIT(0, false); } else { AT_ISSUE(kbW + (size_t)w_lo * 8192, vtbW + (size_t)w_lo * 8192, true); AT_COMMIT(0, true); }
        __syncthreads();
        for (int n = 0; n < nb; ++n) {
            if (n + 1 < nb) AT_ISSUE(kc + (size_t)(n + 1) * 8192, vct, false); else AT_ISSUE(kc, vct, true);
            AT_STEP_STATS(cb, 64 * n, nvis - 1);
            if (n + 1 < nb) AT_COMMIT(cb ^ 1, false); else AT_COMMIT(cb ^ 1, true);
            __syncthreads(); cb ^= 1; }
        float lt = l_run; lt += __shfl_xor(lt, 16); lt += __shfl_xor(lt, 32); const float il_c = lt > 0.f ? 1.0f / lt : 0.f;
#pragma unroll
        for (int dt = 0; dt < 8; ++dt) oa[dt] = (f32x4){0.f, 0.f, 0.f, 0.f};
        if (lane < 64) { *(LAS f32x4*)(ps + 4 * lane) = (f32x4){0.f, 0.f, 0.f, 0.f}; *(LAS f32x4*)(ps + 256 + 4 * lane) = (f32x4){0.f, 0.f, 0.f, 0.f}; }
        for (int n = 0; n < nb; ++n) {
            if (n + 1 < nb) AT_ISSUE(kc + (size_t)(n + 1) * 8192, vct + (size_t)(n + 1) * 8192, true); else AT_ISSUE(kbW + (size_t)w_lo * 8192, vtbW + (size_t)w_lo * 8192, true);
            AT_STEP_FINAL(cb, 64 * n, nvis - 1);
            AT_COMMIT(cb ^ 1, true);
            __syncthreads(); cb ^= 1; }
        const float g_c = sigmoid_f(p.GATE()[(size_t)m * 256 + h * 3 + 0]);
#pragma unroll
        for (int dt = 0; dt < 8; ++dt) res[dt] = oa[dt] * g_c;
    }
    unsigned long long selm0, selm1;
    {
        unsigned long long sm[2];
#pragma unroll
        for (int q2 = 0; q2 < 2; ++q2) { const int tq = t0 + q2, s = lane, cur = tq >> 6; float a = 0.f;
#pragma unroll
            for (int dn = -1; dn <= 3; ++dn) { const int n = 4 * s + dn; if (n >= 0 && n < 255) a += ps[q2 * 256 + n]; }
            const bool causal = s <= cur, forced = (s == 0) || (s == cur) || (s == cur - 1);
            const float score = causal ? a + (forced ? 1e4f : 0.f) : -1e30f; int rank = 0;
#pragma unroll 8
            for (int s2 = 0; s2 < 64; ++s2) { const float v2 = __shfl(score, s2); rank += ((v2 > score) || (v2 == score && s2 < s)) ? 1 : 0; }
            sm[q2] = __ballot(rank < 16 && causal); }
        selm0 = sm[0]; selm1 = sm[1];
    }
    const unsigned long long myU = selm0 | selm1;
    if (lane == 0) *(LAS unsigned long long*)(lds + AT_UM + wave * 8) = myU;
    __syncthreads();
    unsigned long long U = 0ull;
#pragma unroll
    for (int w = 0; w < 8; ++w) U |= *(const LAS unsigned long long*)(lds + AT_UM + w * 8);
    U = __builtin_amdgcn_readfirstlane((unsigned)U) | ((unsigned long long)__builtin_amdgcn_readfirstlane((unsigned)(U >> 32)) << 32);
    const GAS bf16* kbS = (const GAS bf16*)p.KSLC() + (size_t)(bg * 4096) * 128;
    const GAS bf16* vtbS = (const GAS bf16*)p.VSLCT() + (size_t)(bg * 64) * 8192;
    {
#pragma unroll
        for (int dt = 0; dt < 8; ++dt) oa[dt] = (f32x4){0.f, 0.f, 0.f, 0.f};
        l_run = 0.f;
        const int s_first = __builtin_ctzll(U);
        for (int n = 0; n < w_nb; ++n) { const int s = w_lo + n;
            if (n + 1 < w_nb) AT_ISSUE(kbW + (size_t)(s + 1) * 8192, vtbW + (size_t)(s + 1) * 8192, true); else AT_ISSUE(kbS + (size_t)s_first * 8192, vtbS + (size_t)s_first * 8192, true);
            if (64 * s + 63 >= t0 - 511 && 64 * s <= t0 + 1) { if (64 * s >= t0 - 510 && 64 * s + 63 <= t0) AT_STEP_ONLINE(cb, 64 * s, 1, true, 0, 0); else AT_STEP_ONLINE(cb, 64 * s, 0, true, t - 511, t); }
            AT_COMMIT(cb ^ 1, true);
            __syncthreads(); cb ^= 1; }
        float lt = l_run; lt += __shfl_xor(lt, 16); lt += __shfl_xor(lt, 32); const float f = sigmoid_f(p.GATE()[(size_t)m * 256 + h * 3 + 2]) / lt;
#pragma unroll
        for (int dt = 0; dt < 8; ++dt) res[dt] += oa[dt] * f;
    }
    {
#pragma unroll
        for (int dt = 0; dt < 8; ++dt) oa[dt] = (f32x4){0.f, 0.f, 0.f, 0.f};
        l_run = 0.f;
        const unsigned long long mym = qi ? selm1 : selm0;
        int s = __builtin_ctzll(U); U &= U - 1;
        for (;;) { const bool more = U != 0ull; const int sn = more ? __builtin_ctzll(U) : 0; U &= U - 1;
            if (more) AT_ISSUE(kbS + (size_t)sn * 8192, vtbS + (size_t)sn * 8192, true);
            if ((myU >> s) & 1ull) { const bool rowsel = (mym >> s) & 1ull;
                if (64 * s + 63 <= t0) AT_STEP_ONLINE(cb, 64 * s, 1, rowsel, 0, 0); else AT_STEP_ONLINE(cb, 64 * s, 0, rowsel, 0, t); }
            if (more) AT_COMMIT(cb ^ 1, true);
            __syncthreads(); cb ^= 1;
            if (!more) break;
            s = sn; }
        float lt = l_run; lt += __shfl_xor(lt, 16); lt += __shfl_xor(lt, 32); const float f = sigmoid_f(p.GATE()[(size_t)m * 256 + h * 3 + 1]) / lt;
#pragma unroll
        for (int dt = 0; dt < 8; ++dt) res[dt] += oa[dt] * f;
    }
    bf16* op = p.OB() + (size_t)m * 2048 + h * 128 + 4 * c;
#pragma unroll
    for (int dt = 0; dt < 8; ++dt) { u32x2 w; w.x = pk2(res[dt][0], res[dt][1]); w.y = pk2(res[dt][2], res[dt][3]); *(GAS u32x2*)(op + 16 * dt) = w; }
}

template <int KIND> __device__ __forceinline__ void sample_attn(const Params& p, int item, LAS unsigned char* lds) {
    constexpr int NK = KIND == 2 ? 1024 : 512, KPW = NK / 8;
    const int b = item >> 1, g = item & 1, tid = tid_opaque(), wave = tid >> 6, lane = tid & 63;
    LAS float* Qf = (LAS float*)lds;
    LAS float* S = (LAS float*)(lds + 4096);
    LAS float* PT = (LAS float*)(lds + 4096 + 32768);
    LAS float* R = (LAS float*)(lds + 4096 + 65536);
    LAS float* IMP = (LAS float*)(lds + 4096 + 98304);
    LAS int* FLG = (LAS int*)(lds + 4096 + 98304 + 640);
    LAS int* SELL = (LAS int*)(lds + 4096 + 98304 + 1280);
    const float scale = 0.08838834764831845f;
    for (int idx = tid; idx < 1024; idx += NT) Qf[idx] = p.QS()[(size_t)b * 2048 + g * 1024 + idx];
    if (KIND == 2 && tid < 16) SELL[tid] = p.SELG()[item * 16 + tid];
    __syncthreads();
    const float* sbase0 = nullptr; const float* sbase1 = nullptr; bool snew0 = false, snew1 = false;
    if constexpr (KIND == 2) {
        const int sa = SELL[2 * wave], sb2 = SELL[2 * wave + 1]; snew0 = sa >= 128; snew1 = sb2 >= 128;
        const int pa = p.ptab()[b * NPAGE + (snew0 ? 0 : sa >> 1)], pb = p.ptab()[b * NPAGE + (snew1 ? 0 : sb2 >> 1)];
        sbase0 = snew0 ? p.out + O_KVS + (size_t)b * 1024 + 512 + g * 128 : p.cache() + ((size_t)pa * 128 + (sa & 1) * 64) * 1024 + 512 + g * 128;
        sbase1 = snew1 ? p.out + O_KVS + (size_t)b * 1024 + 512 + g * 128 : p.cache() + ((size_t)pb * 128 + (sb2 & 1) * 64) * 1024 + 512 + g * 128; }
    if constexpr (KIND == 0) {
        const int n = wave * 64 + lane; float sc[8];
#pragma unroll
        for (int hh = 0; hh < 8; ++hh) sc[hh] = 0.f;
        const GAS f32x4* kr = (const GAS f32x4*)(p.KCS() + ((size_t)(b * 2 + g) * 512 + (n < 511 ? n : 510)) * 128);
#pragma unroll 4
        for (int d4 = 0; d4 < 32; ++d4) { const f32x4 kv = kr[d4];
#pragma unroll
            for (int hh = 0; hh < 8; ++hh) { const f32x4 qv = *(const LAS f32x4*)(Qf + hh * 128 + 4 * d4); sc[hh] += (kv.x * qv.x + kv.y * qv.y) + (kv.z * qv.z + kv.w * qv.w); } }
#pragma unroll
        for (int hh = 0; hh < 8; ++hh) S[hh * NK + n] = n < 511 ? sc[hh] * scale : -1e30f;
    } else {
        const int c = lane >> 4, j = lane & 15;
        bf16x8 qf[4];
#pragma unroll
        for (int kk = 0; kk < 4; ++kk) { f32x4 a = {0.f, 0.f, 0.f, 0.f}, bq = {0.f, 0.f, 0.f, 0.f};
            if (j < 8) { a = *(const LAS f32x4*)(Qf + j * 128 + 32 * kk + 8 * c); bq = *(const LAS f32x4*)(Qf + j * 128 + 32 * kk + 8 * c + 4); }
            qf[kk] = pack_p(a, bq); }
        for (int tb = 0; tb < KPW / 16; tb += 4) {
            f32x4 x0[4][4], x1[4][4]; bool vld[4];
#pragma unroll
            for (int u = 0; u < 4; ++u) { const int tl = tb + u; const int slot = wave * KPW + tl * 16 + j; const float* kr; bool valid = true;
                if constexpr (KIND == 1) { kr = slot < 511 ? p.state() + ((size_t)b * 512 + slot + 1) * 512 + g * 128 : p.out + O_WINS + ((size_t)b * 512 + 511) * 512 + g * 128; }
                else { const int kq = slot & 63; const bool hi = (tl >= 4);
                    const float* bb = hi ? sbase1 : sbase0; const bool nw = hi ? snew1 : snew0; valid = !nw || kq == 0; kr = bb + (nw ? 0 : kq * 1024); }
                vld[u] = valid;
#pragma unroll
                for (int kk = 0; kk < 4; ++kk) { x0[u][kk] = *(const GAS f32x4*)(kr + 32 * kk + 8 * c); x1[u][kk] = *(const GAS f32x4*)(kr + 32 * kk + 8 * c + 4); } }
#pragma unroll
            for (int u = 0; u < 4; ++u) { const int tl = tb + u; f32x4 acc = {0.f, 0.f, 0.f, 0.f};
#pragma unroll
                for (int kk = 0; kk < 4; ++kk) acc = MFMA16(pack_p(x0[u][kk], x1[u][kk]), qf[kk], acc);
#pragma unroll
                for (int e = 0; e < 4; ++e) { const bool v = __shfl((int)vld[u], 4 * c + e) != 0; if (j < 8) S[j * NK + wave * KPW + tl * 16 + 4 * c + e] = v ? acc[e] * scale : -1e30f; } } }
    }
    __syncthreads();
    { float vals[NK / 64]; float mx = -1e30f;
#pragma unroll
      for (int k = 0; k < NK / 64; ++k) { vals[k] = S[wave * NK + lane + 64 * k]; mx = fmaxf(mx, vals[k]); }
      mx = wave_max(mx); float sum = 0.f;
#pragma unroll
      for (int k = 0; k < NK / 64; ++k) { vals[k] = vals[k] > -0.5e30f ? __expf(vals[k] - mx) : 0.f; sum += vals[k]; }
      sum = wave_sum(sum); const float inv = 1.0f / sum;
#pragma unroll
      for (int k = 0; k < NK / 64; ++k) PT[(lane + 64 * k) * 8 + wave] = vals[k] * inv; }
    __syncthreads();
    { float a0[8], a1[8];
#pragma unroll
      for (int hh = 0; hh < 8; ++hh) { a0[hh] = 0.f; a1[hh] = 0.f; }
      for (int kb = 0; kb < KPW; kb += 32) {
          f32x2 vv[32];
#pragma unroll
          for (int u = 0; u < 32; ++u) { const int kq = kb + u, slot = wave * KPW + kq; const float* vr;
              if constexpr (KIND == 0) vr = p.VCS() + ((size_t)(b * 2 + g) * 512 + (slot < 511 ? slot : 510)) * 128;
              else if constexpr (KIND == 1) vr = slot < 511 ? p.state() + ((size_t)b * 512 + slot + 1) * 512 + 256 + g * 128 : p.out + O_WINS + ((size_t)b * 512 + 511) * 512 + 256 + g * 128;
              else { const int k6 = slot & 63; const bool hi = kq >= 64; vr = (hi ? sbase1 : sbase0) + 256 + ((hi ? snew1 : snew0) ? 0 : k6 * 1024); }
              vv[u] = *(const GAS f32x2*)(vr + 2 * lane); }
#pragma unroll
          for (int u = 0; u < 32; ++u) { const int slot = wave * KPW + kb + u; const f32x2 v = vv[u]; const f32x4 p0 = *(const LAS f32x4*)(PT + slot * 8), p1 = *(const LAS f32x4*)(PT + slot * 8 + 4);
              a0[0] += p0.x * v.x; a1[0] += p0.x * v.y; a0[1] += p0.y * v.x; a1[1] += p0.y * v.y; a0[2] += p0.z * v.x; a1[2] += p0.z * v.y; a0[3] += p0.w * v.x; a1[3] += p0.w * v.y;
              a0[4] += p1.x * v.x; a1[4] += p1.x * v.y; a0[5] += p1.y * v.x; a1[5] += p1.y * v.y; a0[6] += p1.z * v.x; a1[6] += p1.z * v.y; a0[7] += p1.w * v.x; a1[7] += p1.w * v.y; } }
#pragma unroll
      for (int hh = 0; hh < 8; ++hh) *(LAS f32x2*)(R + (wave * 8 + hh) * 128 + 2 * lane) = (f32x2){a0[hh], a1[hh]}; }
    if constexpr (KIND == 0) {
        if (tid < 129) { const int s = tid; float a = 0.f;
            for (int dn = -1; dn <= 3; ++dn) { const int n = 4 * s + dn; if (n >= 0 && n < 511) { const f32x4 x = *(const LAS f32x4*)(PT + n * 8), y = *(const LAS f32x4*)(PT + n * 8 + 4); a += ((x.x + x.y) + (x.z + x.w)) + ((y.x + y.y) + (y.z + y.w)); } }
            IMP[s] = a + ((s == 0 || s >= 127) ? 1e4f : 0.f); }
    }
    __syncthreads();
    if constexpr (KIND == 0) {
        if (tid < 129) { const float v = IMP[tid]; int rank = 0; for (int s2 = 0; s2 < 129; ++s2) { const float v2 = IMP[s2]; rank += ((v2 > v) || (v2 == v && s2 < tid)) ? 1 : 0; } FLG[tid] = rank < 16 ? 1 : 0; }
    }
    { const int hh = tid >> 6, hq = g * 8 + hh; f32x2 o = {0.f, 0.f};
#pragma unroll
      for (int w = 0; w < 8; ++w) { const f32x2 x = *(const LAS f32x2*)(R + (w * 8 + hh) * 128 + 2 * lane); o.x += x.x; o.y += x.y; }
      const float gt = p.GS()[b * 48 + hq * 3 + (KIND == 0 ? 0 : KIND == 1 ? 2 : 1)]; const size_t oo = (size_t)b * 2048 + hq * 128 + 2 * lane;
      if constexpr (KIND == 0) *(GAS f32x2*)(p.OSFC() + oo) = o * gt;
      else if constexpr (KIND == 1) *(GAS f32x2*)(p.OSFW() + oo) = o * gt;
      else { const f32x2 oc = *(const GAS f32x2*)(p.OSFC() + oo), ow = *(const GAS f32x2*)(p.OSFW() + oo); *(GAS unsigned*)(p.OSB() + oo) = pk2(oc.x + ow.x + o.x * gt, oc.y + ow.y + o.y * gt); } }
    __syncthreads();
    if constexpr (KIND == 0) { if (tid < 129 && FLG[tid]) { int idx = 0; for (int s2 = 0; s2 < tid; ++s2) idx += FLG[s2]; if (idx < 16) p.SELG()[item * 16 + idx] = tid; } }
    __syncthreads();
}
#ifndef PROBE_MASK
#define PROBE_MASK 0
#endif

constexpr int NPHASE = 14;
template <int PH> __device__ __forceinline__ void run_phase(const Params& p, LAS unsigned char* lds) {
    const int tid = tid_opaque(), wave = tid >> 6, lane = tid & 63, G = gridDim.x; const int gw = blockIdx.x * 8 + wave, NGW = G * 8;
    if constexpr (PH == 0) { phase0(p, lds); }
    if constexpr (PH == 1) {
        if (blockIdx.x == 0 && tid < 256) { float a[32];
#pragma unroll
            for (int rr = 0; rr < 32; ++rr) a[rr] = p.CBIAS()[((tid >> 7) * 32 + rr) * 128 + (tid & 127)];
            float sacc = 0.f;
#pragma unroll
            for (int rr = 0; rr < 32; ++rr) sacc += a[rr];
            p.CBIASF()[tid] = sacc; }
        if (blockIdx.x & 1) cmp_stream_gemm(p, lds);
        { pg8::Gemm g{p.XB(), p.W_ain(), MP, 4096, 2048, 2048, 2048}; pg8::StaticOrder S; S.init(MP, 4096, G, (int)blockIdx.x); EpiA1 E{p.U(), p.V(), p.x_ssq(), p.v_ssq()};
          pg8::gemm_phase<EpiA1, pg8::StaticOrder, true, true>(lds, g, S, E); }
        if (!(blockIdx.x & 1)) cmp_stream_gemm(p, lds);
        { SkEpi e{1, p.xs_ssq(), p.US(), p.VS(), nullptr, nullptr, nullptr}; skinny_gemm(lds, p.XSB(), 2048, p.W_ain(), 4096, e); }
    }
    if constexpr (PH == 2) {
        if constexpr ((PROBE_MASK >> 21) & 1) { cmp_stream_gemm(p, lds); __syncthreads(); }
        gating_block(p, lds);
        for (int i = gw; i < MS; i += NGW) sample_gating_row(p, i, lane);
        __syncthreads();
        cmp_w2_to_lds(p, lds); __syncthreads();
        for (int it = gw; it < 64 * 32; it += NGW) { const int bg = it >> 5, i0 = (it & 31) * 16; const size_t r0 = (size_t)bg * 512 + i0;
            f32x4 kc[8], vc[8]; cmp_finish16<1>(p.FCMPS() + r0 * 256, p.FCMPS() + (32768 + r0) * 256, 0, i0, 511, lds, p.k_norm(), p.ROPE(), lane, kc, vc);
            const int c = lane >> 4, j = lane & 15;
            if (i0 + j < 511) {
#pragma unroll
                for (int dt = 0; dt < 8; ++dt) { *(GAS f32x4*)(p.KCS() + (r0 + j) * 128 + 16 * dt + 4 * c) = kc[dt]; *(GAS f32x4*)(p.VCS() + (r0 + j) * 128 + 16 * dt + 4 * c) = vc[dt]; } } }
        __syncthreads();
    }
    if constexpr (PH == 3) {
        { pg8::Gemm g{p.GT(), p.W_aout(), MP, 2048, 2048, 2048, 2048}; pg8::StaticOrder S; S.init(MP, 2048, G, (int)blockIdx.x); EpiRes E{nullptr, p.XB(), nullptr, p.H1B(), p.h1_ssq()};
          pg8::gemm_phase<EpiRes, pg8::StaticOrder, true, true>(lds, g, S, E); }
        { SkEpi e{2, nullptr, p.H1S(), nullptr, p.x_s(), p.H1SB(), p.h1s_ssq()}; skinny_gemm(lds, p.GTS(), 2048, p.W_aout(), 2048, e); }
    }
    if constexpr (PH == 4 || PH == 12) {
        const bool l1 = PH == 12;
        { pg8::Gemm g{l1 ? p.H3B() : p.H1B(), l1 ? p.W_up1() : p.W_up0(), MP, 8192, 2048, 2048, 2048}; pg8::StaticOrder S; S.init(MP, 8192, G, (int)blockIdx.x); EpiUp E{p.ACT(), -MP, l1 ? p.h3_ssq() : p.h1_ssq()};
          pg8::gemm_phase<EpiUp, pg8::StaticOrder, true, true>(lds, g, S, E); }
        { SkEpi e{3, l1 ? p.h3s_ssq() : p.h1s_ssq(), nullptr, nullptr, nullptr, p.ACTS(), nullptr}; skinny_gemm(lds, l1 ? p.H3SB() : p.H1SB(), 2048, l1 ? p.W_up1() : p.W_up0(), 8192, e); }
    }
    if constexpr (PH == 5) {
        { pg8::Gemm g{p.ACT(), p.W_dn0(), MP, 2048, 8192, 64, 64, (size_t)MP * 128, (size_t)2048 * 128}; pg8::StaticOrder S; S.init(MP, 2048, G, (int)blockIdx.x); EpiRes E{nullptr, p.H1B(), nullptr, p.H2B(), p.h2_ssq()};
          pg8::gemm_phase<EpiRes, pg8::StaticOrder, true, true>(lds, g, S, E); }
        { SkEpi e{2, nullptr, p.H2S(), nullptr, p.H1S(), p.H2SB(), p.h2s_ssq()}; skinny_gemm_k4(lds, p.ACTS(), p.W_dn0(), e, p.H1(), p.bar() + 8192 + 64 * 64 + 64); }
    }
    if constexpr (PH == 6) {
        { pg8::Gemm g{p.H2B(), p.W_kvq(), MP, NKVQ, 2048, 2048, 2048}; pg8::StaticOrder S; S.init(MP, NKVQ, G, (int)blockIdx.x); EpiKvq E{p.out + O_KVP, p.WINF(), p.QRAW(), p.GATE(), p.h2_ssq(), p.ACMP()};
          pg8::gemm_phase<EpiKvq, pg8::StaticOrder, true, true>(lds, g, S, E); }
        { SkEpi e{0, p.h2s_ssq(), p.KVQS(), nullptr, nullptr, nullptr, nullptr}; skinny_gemm(lds, p.H2SB(), 2048, p.W_kvq(), NKVQ, e, G - 32); }
    }
    if constexpr (PH == 7) {
        unsigned* hand = p.bar() + 8192;
        if (blockIdx.x < 32) { const int ks = (int)blockIdx.x >> 3;
          pg8::Gemm g{p.ACMP() + ks * 512, p.W_cmp() + ks * 512, 2048, 512, 512, 2048, 2048}; pg8::DiagOrder S{8, 4, 8, (int)blockIdx.x & 7}; EpiPlain E{p.FCMP8() + (size_t)ks * 2048 * 256};
          pg8::gemm_phase<EpiPlain, pg8::DiagOrder, true, true>(lds, g, S, E);
          VM_WAIT(); __syncthreads();
          if (tid == 0) { __builtin_amdgcn_fence(__ATOMIC_RELEASE, "agent"); asm volatile("s_waitcnt vmcnt(0)" ::: "memory"); __hip_atomic_fetch_add(hand + 64 * 64, 1u, __ATOMIC_RELAXED, __HIP_MEMORY_SCOPE_AGENT); } }
        { FinRow ra, rb; int m = gw;
          if (m < MP) finish_row_load(p, m, lane, ra);
          while (m < MP) { const int m1 = m + NGW; if (m1 < MP) finish_row_load(p, m1, lane, rb);
              finish_row_prompt(p, m, lane, ra);
              if (m1 >= MP) break;
              const int m2 = m1 + NGW; if (m2 < MP) finish_row_load(p, m2, lane, ra);
              finish_row_prompt(p, m1, lane, rb);
              m = m2; } }
        for (int it = blockIdx.x; it < 512; it += G) vt_item(p, it, lds);
        __syncthreads();
        if (blockIdx.x < 32) {
          if (blockIdx.x < 8) {
            if (tid < 64) { unsigned spins = 0; while (__builtin_amdgcn_readfirstlane(__hip_atomic_load(hand + 64 * 64, __ATOMIC_RELAXED, __HIP_MEMORY_SCOPE_AGENT)) < 32u && ++spins < (1u << 20)) __builtin_amdgcn_s_sleep(2);
                __builtin_amdgcn_fence(__ATOMIC_ACQUIRE, "agent"); asm volatile("s_waitcnt vmcnt(0)" ::: "memory"); }
            __syncthreads();
        cmp_w2_to_lds(p, lds);
        if (blockIdx.x < 8) {
            const size_t R0 = (size_t)blockIdx.x * 128;
            for (int half = 0; half < 2; ++half) for (int o0 = 0; o0 < 129 * 64; o0 += NT * 8) { f32x4 acc4[8];
#pragma unroll
                for (int k = 0; k < 8; ++k) { const int o = o0 + tid + NT * k; acc4[k] = (f32x4){0.f, 0.f, 0.f, 0.f};
                    if (o < 129 * 64 && R0 + (o >> 6) < 1024) { const float* src = p.FCMP8() + ((size_t)half * 1024 + R0 + (o >> 6)) * 256 + (o & 63) * 4;
                        acc4[k] = (*(const GAS f32x4*)src + *(const GAS f32x4*)(src + (size_t)2048 * 256)) + (*(const GAS f32x4*)(src + (size_t)2 * 2048 * 256) + *(const GAS f32x4*)(src + (size_t)3 * 2048 * 256)); } }
#pragma unroll
                for (int k = 0; k < 8; ++k) { const int o = o0 + tid + NT * k; if (o < 129 * 64 && R0 + (o >> 6) < 1024) *(GAS f32x4*)(p.FCMP() + ((size_t)half * 1024 + R0 + (o >> 6)) * 256 + (o & 63) * 4) = acc4[k]; } }
            VM_WAIT(); }
        __syncthreads();
        for (int it = gw; it < 4 * 16; it += NGW) { const int bg = it >> 4, i0 = (it & 15) * 16; const size_t r0 = (size_t)bg * 256 + i0;
            f32x4 kc[8], vc[8]; cmp_finish16<1>(p.FCMP() + r0 * 256, p.FCMP() + (1024 + r0) * 256, 0, i0, 255, lds, p.k_norm(), p.ROPE(), lane, kc, vc);
            const int c = lane >> 4, j = lane & 15, i = i0 + j; const bool ok = i < 255;
#pragma unroll
            for (int dt = 0; dt < 8; ++dt) { const f32x4 kk4 = ok ? kc[dt] : (f32x4){0.f, 0.f, 0.f, 0.f}, vv4 = ok ? vc[dt] : (f32x4){0.f, 0.f, 0.f, 0.f};
                u32x2 w; w.x = pk2(kk4[0], kk4[1]); w.y = pk2(kk4[2], kk4[3]); *(GAS u32x2*)(p.KC() + (r0 + j) * 128 + 16 * dt + 4 * c) = w;
                bf16* vt = p.VCT() + ((size_t)(bg * 4 + (i >> 6)) * 128 + 16 * dt + 4 * c) * 64 + (i & 63);
                vt[0] = (bf16)f2bf(vv4[0]); vt[64] = (bf16)f2bf(vv4[1]); vt[128] = (bf16)f2bf(vv4[2]); vt[192] = (bf16)f2bf(vv4[3]); } }
        __syncthreads();
          }
        } else if (blockIdx.x < 160) { const bool isw = blockIdx.x >= 96; const int item = (int)blockIdx.x - (isw ? 96 : 32);
            if (tid < 64) finish_row_sample(p, item >> 1, lane);
            VM_WAIT(); __syncthreads();
            if (!isw) {
                sample_attn<0>(p, item, lds);
                VM_WAIT(); __syncthreads();
                if (tid < 64) { unsigned* flag = hand + item * 64; unsigned spins = 0;
                    while (__builtin_amdgcn_readfirstlane(__hip_atomic_load(flag, __ATOMIC_RELAXED, __HIP_MEMORY_SCOPE_AGENT)) == 0u && ++spins < (1u << 20)) __builtin_amdgcn_s_sleep(2);
                    __builtin_amdgcn_fence(__ATOMIC_ACQUIRE, "agent"); asm volatile("s_waitcnt vmcnt(0)" ::: "memory"); }
                __syncthreads();
                sample_attn<2>(p, item, lds);
            } else {
                sample_attn<1>(p, item, lds);
                VM_WAIT(); __syncthreads();
                if (tid == 0) { __builtin_amdgcn_fence(__ATOMIC_RELEASE, "agent"); asm volatile("s_waitcnt vmcnt(0)" ::: "memory"); __hip_atomic_store(hand + item * 64, 1u, __ATOMIC_RELAXED, __HIP_MEMORY_SCOPE_AGENT); }
                late_weights(p, lds, 0, 2 * (G - 160) + item, 2 * (G - 160) + 64); late_weights(p, lds, 1, 2 * (G - 160) + item, 2 * (G - 160) + 64); }
        } else { const int k = (int)blockIdx.x - 160, nv = 2 * (G - 160) + 64;
            late_weights(p, lds, 0, 2 * k, nv); late_weights(p, lds, 0, 2 * k + 1, nv); late_weights(p, lds, 1, 2 * k, nv); late_weights(p, lds, 1, 2 * k + 1, nv); }
    }
    if constexpr (PH == 10) {
        for (int bi = blockIdx.x; bi < 1024; bi += G) { int tile = bi >> 2; const int bg = bi & 3; if (tile & 64) tile ^= 63;
            attn_prompt_unit(p, bg >> 1, bg & 1, tile * 16, lds, tid); }
    }
    if constexpr (PH == 11) {
        { pg8::Gemm g{p.OB(), p.W_bout(), MP, 2048, 2048, 2048, 2048}; pg8::StaticOrder S; S.init(MP, 2048, G, (int)blockIdx.x); EpiRes E{nullptr, p.H2B(), nullptr, p.H3B(), p.h3_ssq()};
          pg8::gemm_phase<EpiRes, pg8::StaticOrder, true, true>(lds, g, S, E); }
        { SkEpi e{2, nullptr, p.H3S(), nullptr, p.H2S(), p.H3SB(), p.h3s_ssq()}; skinny_gemm(lds, p.OSB(), 2048, p.W_bout(), 2048, e); }
    }
    if constexpr (PH == 13) {
        { pg8::Gemm g{p.ACT(), p.W_dn1(), MP, 2048, 8192, 64, 64, (size_t)MP * 128, (size_t)2048 * 128}; pg8::StaticOrder S; S.init(MP, 2048, G, (int)blockIdx.x); EpiRes E{nullptr, p.H3B(), p.out + O_YP, nullptr, nullptr};
          pg8::gemm_phase<EpiRes, pg8::StaticOrder, true, true>(lds, g, S, E); }
        { SkEpi e{2, nullptr, p.out + O_YS, nullptr, p.H3S(), nullptr, nullptr}; skinny_gemm_k4(lds, p.ACTS(), p.W_dn1(), e, p.H1() + (size_t)4 * 32 * 2048, p.bar() + 8192 + 64 * 64 + 128); }
    }
}

#ifndef MK_N_LAUNCHES
#define MK_N_LAUNCHES 1
#endif
#if MK_N_LAUNCHES != 1
template <int PH> __global__ void __launch_bounds__(NT, 2) k_phase(Params p) {
    extern __shared__ __attribute__((aligned(16))) unsigned char lds_raw[];
    run_phase<PH>(p, (LAS unsigned char*)lds_raw);
}
template <int PH> static void launch_phase(const Params& p, int grid, hipStream_t stream) {
    static bool attr = false;
    if (!attr) { (void)hipFuncSetAttribute((const void*)k_phase<PH>, hipFuncAttributeMaxDynamicSharedMemorySize, LDS_BYTES); attr = true; }
    hipLaunchKernelGGL(k_phase<PH>, dim3(grid), dim3(NT), LDS_BYTES, stream, p);
}
template <int PH> static void launch_all(const Params& p, int grid, hipStream_t stream) {
    launch_phase<PH>(p, grid, stream);
    if constexpr (PH + 1 < NPHASE) launch_all<PH + 1>(p, grid, stream);
}
#else
#define GRID_BAR() do { XcdBarrier b_; b_.bar = p.bar(); b_.x = xb_xcc_id(); b_.st = (volatile LAS unsigned*)(lds + MISC_OFF); xcd_barrier(b_); if constexpr ((PROBE_MASK >> 23) & 1) xcd_barrier(b_); } while (0)
#define RUNP(k) do { run_phase<k>(p, lds); if constexpr ((PROBE_MASK >> k) & 1) { GRID_BAR(); run_phase<k>(p, lds); } } while (0)
__global__ void __launch_bounds__(NT, 2) k_mega(Params p) {
    extern __shared__ __attribute__((aligned(16))) unsigned char lds_raw[];
    LAS unsigned char* lds = (LAS unsigned char*)lds_raw;
    if (threadIdx.x < 4) ((LAS unsigned*)(lds + MISC_OFF))[threadIdx.x] = 0u;
    __syncthreads();
    (void)xcd_barrier_post(p.bar(), (volatile LAS unsigned*)(lds + MISC_OFF));
    RUNP(0); GRID_BAR();
    RUNP(1); GRID_BAR();
    RUNP(2); GRID_BAR();
    RUNP(3); GRID_BAR();
    RUNP(4); GRID_BAR();
    RUNP(5); GRID_BAR();
    RUNP(6); GRID_BAR();
    RUNP(7); GRID_BAR();
    RUNP(10); GRID_BAR();
    RUNP(11); GRID_BAR();
    RUNP(12); GRID_BAR();
    RUNP(13);
}
#endif

extern "C" void kernel_launch(void* const* d_in, const int* in_sizes, int n_in, void* d_out, int out_size, void* d_ws, size_t ws_size, hipStream_t stream) {
    (void)in_sizes; (void)n_in; (void)out_size; (void)ws_size;
    Params p{};
    for (int i = 0; i < 24; ++i) p.in[i] = d_in[i];
    p.out = (float*)d_out; p.ws = (unsigned char*)d_ws;
    static int grid = 0;
    if (grid == 0) { int dev = 0, cus = 0; if (hipGetDevice(&dev) != hipSuccess || hipDeviceGetAttribute(&cus, hipDeviceAttributeMultiprocessorCount, dev) != hipSuccess || cus <= 0) cus = 256; grid = cus; }
#if MK_N_LAUNCHES != 1
    launch_all<0>(p, grid, stream);
#else
    static bool attr = false;
    if (!attr) { (void)hipFuncSetAttribute((const void*)k_mega, hipFuncAttributeMaxDynamicSharedMemorySize, LDS_BYTES); attr = true; }
    (void)hipMemsetAsync(d_ws, 0, 65536, stream);
    hipLaunchKernelGGL(k_mega, dim3(grid), dim3(NT), LDS_BYTES, stream, p);
#endif
}
```
